# Optimizing an MI355X kernel written in HIP

```python
import math
import jax
import jax.numpy as jnp
from jax import lax
import numpy as np

D_MODEL = 1024
BATCH = 4
SEQ = 4096
DEPTH = 1
DEC_BATCH = 8
DEC_SEQ = 16
PAST_LEN = 2048

CHUNK = 64
N_PREV_CHUNKS = 8
HEAD_DIM = 64
A_HEADS = 8
A_WIDTH = A_HEADS * HEAD_DIM
A_MAX_REL = 64
B_HEADS = 8
B_KV_HEADS = 2
B_GROUP = B_HEADS // B_KV_HEADS
B_WIDTH = B_HEADS * HEAD_DIM
B_KV_WIDTH = B_KV_HEADS * HEAD_DIM
MIX_WIDTH = A_WIDTH + B_WIDTH
IDX_HEADS = 8
IDX_DIM = 64
TOPK_MAX = 256
N_BUCKETS = 32
T5_MAX_DIST = 128
MEM_LEN = 256
MEM_HEADS = 4
MEM_HEAD_DIM = 128
MEM_WIDTH = MEM_HEADS * MEM_HEAD_DIM
D_FF = 2816
CONV_W = 3
Q_BLOCK = 128
IN_SIZES = (A_WIDTH, A_WIDTH, A_WIDTH, B_WIDTH, B_KV_WIDTH, B_KV_WIDTH, IDX_HEADS * IDX_DIM, IDX_DIM, IDX_HEADS)
IN_WIDTH = sum(IN_SIZES)
ALPHA = (2 * DEPTH) ** 0.25
BETA = (8 * DEPTH) ** -0.25
LN_EPS = 1e-5
ATTN_SCALE = HEAD_DIM ** -0.5
NEG = -1e30

kernel_name = 'hybrid_streaming_encoder_step'


def layer_norm(x, g, b):
    xf = x.astype(jnp.float32)
    mu = jnp.mean(xf, axis=-1, keepdims=True)
    var = jnp.mean(jnp.square(xf - mu), axis=-1, keepdims=True)
    return ((xf - mu) * lax.rsqrt(var + LN_EPS) * g + b).astype(x.dtype)


def split_in(z):
    b, t = z.shape[:2]
    parts, off = [], 0
    for n in IN_SIZES:
        parts.append(z[..., off:off + n])
        off += n
    qa, ka, va, qb, kb, vb, qi, ki, wi = parts
    hd = lambda a, h, d: a.reshape(b, t, h, d)
    return (hd(qa, A_HEADS, HEAD_DIM), hd(ka, A_HEADS, HEAD_DIM), hd(va, A_HEADS, HEAD_DIM),
            hd(qb, B_HEADS, HEAD_DIM), hd(kb, B_KV_HEADS, HEAD_DIM), hd(vb, B_KV_HEADS, HEAD_DIM),
            hd(qi, IDX_HEADS, IDX_DIM), ki, wi * IDX_HEADS ** -0.5)


def clipped_rel_bias(table, rel):
    return table[jnp.clip(rel, -A_MAX_REL, A_MAX_REL) + A_MAX_REL]


def t5_bucket(rel):
    half = N_BUCKETS // 2
    max_exact = half // 2
    n = jnp.abs(rel)
    log_ratio = jnp.log(jnp.maximum(n, 1).astype(jnp.float32) / max_exact) / math.log(T5_MAX_DIST / max_exact)
    large = jnp.minimum(max_exact + (log_ratio * (half - max_exact)).astype(jnp.int32), half - 1)
    return jnp.where(rel < 0, half, 0) + jnp.where(n < max_exact, n, large)


def band_attend_prompt(q, k, v, table):
    b, t = q.shape[:2]
    n_c = t // CHUNK
    band = (N_PREV_CHUNKS + 1) * CHUNK
    pad = ((0, 0), (N_PREV_CHUNKS * CHUNK, 0), (0, 0), (0, 0))
    kc = jnp.pad(k, pad).reshape(b, n_c + N_PREV_CHUNKS, CHUNK, A_HEADS, HEAD_DIM)
    vc = jnp.pad(v, pad).reshape(b, n_c + N_PREV_CHUNKS, CHUNK, A_HEADS, HEAD_DIM)
    idx = jnp.arange(n_c)[:, None] + jnp.arange(N_PREV_CHUNKS + 1)[None, :]
    kb = kc[:, idx].reshape(b, n_c, band, A_HEADS, HEAD_DIM)
    vb = vc[:, idx].reshape(b, n_c, band, A_HEADS, HEAD_DIM)
    qc = q.reshape(b, n_c, CHUNK, A_HEADS, HEAD_DIM)
    rel = jnp.arange(CHUNK)[:, None] + N_PREV_CHUNKS * CHUNK - jnp.arange(band)[None, :]
    bias = clipped_rel_bias(table, rel).transpose(2, 0, 1)
    kpos = (jnp.arange(n_c)[:, None] - N_PREV_CHUNKS) * CHUNK + jnp.arange(band)[None, :]
    s = jnp.einsum('bcqhd,bckhd->bchqk', qc, kb).astype(jnp.float32) * ATTN_SCALE + bias
    s = jnp.where((kpos >= 0)[None, :, None, None, :], s, NEG)
    p = jax.nn.softmax(s, axis=-1).astype(v.dtype)
    return jnp.einsum('bchqk,bckhd->bcqhd', p, vb).reshape(b, t, A_WIDTH)


def band_attend_sample(q, k, v, table):
    b, s_len = q.shape[:2]
    n_keys = k.shape[1]
    rel = (n_keys - s_len + jnp.arange(s_len))[:, None] - jnp.arange(n_keys)[None, :]
    bias = clipped_rel_bias(table, rel).transpose(2, 0, 1)
    s = jnp.einsum('bqhd,bkhd->bhqk', q, k).astype(jnp.float32) * ATTN_SCALE + bias
    p = jax.nn.softmax(s, axis=-1).astype(v.dtype)
    return jnp.einsum('bhqk,bkhd->bqhd', p, v).reshape(b, s_len, A_WIDTH)


def dsa_attend(q, qi, wi, qpos, k, v, ki, admissible, top_k, t5_table):
    b, nq = q.shape[:2]
    logits = jnp.einsum('bqhe,ble->bqhl', qi, ki).astype(jnp.float32) * IDX_DIM ** -0.5
    score = jnp.einsum('bqh,bqhl->bql', wi.astype(jnp.float32), jax.nn.relu(logits))
    score = jnp.where(admissible[None], score, -jnp.inf)
    top_val, sel = lax.top_k(score, top_k)
    gather = jax.vmap(lambda rows, ids: rows[ids])
    ks, vs = gather(k, sel), gather(v, sel)
    bias = t5_table[t5_bucket(qpos[None, :, None] - sel)]
    bias = bias.reshape(b, nq, top_k, B_KV_HEADS, B_GROUP).transpose(0, 1, 3, 4, 2)
    qg = q.reshape(b, nq, B_KV_HEADS, B_GROUP, HEAD_DIM)
    s = jnp.einsum('bqgrd,bqkgd->bqgrk', qg, ks).astype(jnp.float32) * ATTN_SCALE + bias
    s = jnp.where(jnp.isfinite(top_val)[:, :, None, None, :], s, NEG)
    p = jax.nn.softmax(s, axis=-1).astype(v.dtype)
    return jnp.einsum('bqgrk,bqkgd->bqgrd', p, vs).reshape(b, nq, B_WIDTH)


def dsa_prompt(q, k, v, qi, ki, wi, t5_table):
    b, t = q.shape[:2]
    top_k = min(TOPK_MAX, t // 4)
    key_idx = jnp.arange(t)

    def block(i):
        q0 = i * Q_BLOCK
        sl = lambda a: lax.dynamic_slice_in_dim(a, q0, Q_BLOCK, axis=1)
        qpos = q0 + jnp.arange(Q_BLOCK)
        adm = key_idx[None, :] < ((qpos // CHUNK + 1) * CHUNK)[:, None]
        return dsa_attend(sl(q), sl(qi), sl(wi), qpos, k, v, ki, adm, top_k, t5_table)

    out = lax.map(block, jnp.arange(t // Q_BLOCK))
    return out.transpose(1, 0, 2, 3).reshape(b, t, B_WIDTH)


def mem_kv(mem, w_k, w_v):
    b = mem.shape[0]
    return ((mem @ w_k).reshape(b, MEM_LEN, MEM_HEADS, MEM_HEAD_DIM),
            (mem @ w_v).reshape(b, MEM_LEN, MEM_HEADS, MEM_HEAD_DIM))


def mem_attend(x, mk, mv, w_q, w_o):
    b, t = x.shape[:2]
    q = (x @ w_q).reshape(b, t, MEM_HEADS, MEM_HEAD_DIM)
    s = jnp.einsum('bthd,bmhd->bhtm', q, mk).astype(jnp.float32) * MEM_HEAD_DIM ** -0.5
    p = jax.nn.softmax(s, axis=-1).astype(mv.dtype)
    return jnp.einsum('bhtm,bmhd->bthd', p, mv).reshape(b, t, MEM_WIDTH) @ w_o


def conv_ffn(x, g_hist, w_up, w_conv, b_conv, w_down):
    t = x.shape[1]
    u, g = jnp.split(x @ w_up, 2, axis=-1)
    gp = jnp.concatenate([g_hist, g], axis=1)
    gc = b_conv + sum(w_conv[j] * gp[:, j:j + t] for j in range(CONV_W))
    h = u * jax.nn.gelu(gc)
    return h @ w_down, gp[:, t:]


def setup_inputs(seed: int = 0) -> dict:
    key = jax.random.key(seed)
    ks = iter(jax.random.split(key, 32))
    nrm = lambda shape, scale=1.0: scale * jax.random.normal(next(ks), shape, jnp.float32)
    a_cache = min(N_PREV_CHUNKS * CHUNK, PAST_LEN)
    return {
        'x_prompt': nrm((BATCH, SEQ, D_MODEL)),
        'x_sample': nrm((DEC_BATCH, DEC_SEQ, D_MODEL)),
        'cache_a_k': nrm((DEPTH, DEC_BATCH, a_cache, A_HEADS, HEAD_DIM)),
        'cache_a_v': nrm((DEPTH, DEC_BATCH, a_cache, A_HEADS, HEAD_DIM)),
        'cache_b_k': nrm((DEPTH, DEC_BATCH, PAST_LEN, B_KV_HEADS, HEAD_DIM)),
        'cache_b_v': nrm((DEPTH, DEC_BATCH, PAST_LEN, B_KV_HEADS, HEAD_DIM)),
        'cache_b_kidx': nrm((DEPTH, DEC_BATCH, PAST_LEN, IDX_DIM)),
        'cache_mem_k': nrm((DEPTH, DEC_BATCH, MEM_LEN, MEM_HEADS, MEM_HEAD_DIM)),
        'cache_mem_v': nrm((DEPTH, DEC_BATCH, MEM_LEN, MEM_HEADS, MEM_HEAD_DIM)),
        'state_ffn_conv': nrm((DEPTH, DEC_BATCH, CONV_W - 1, D_FF)),
        'mem_prompt': nrm((BATCH, MEM_LEN, D_MODEL)),
        'w_in': nrm((DEPTH, D_MODEL, IN_WIDTH), D_MODEL ** -0.5),
        'a_rel_bias': nrm((DEPTH, 2 * A_MAX_REL + 1, A_HEADS), 0.1),
        't5_bias': nrm((N_BUCKETS, B_HEADS), 0.1),
        'w_o': nrm((DEPTH, MIX_WIDTH, D_MODEL), BETA * MIX_WIDTH ** -0.5),
        'ln1_g': 1.0 + nrm((DEPTH, D_MODEL), 0.01),
        'ln1_b': nrm((DEPTH, D_MODEL), 0.01),
        'w_mq': nrm((DEPTH, D_MODEL, MEM_WIDTH), D_MODEL ** -0.5),
        'w_mk': nrm((DEPTH, D_MODEL, MEM_WIDTH), D_MODEL ** -0.5),
        'w_mv': nrm((DEPTH, D_MODEL, MEM_WIDTH), D_MODEL ** -0.5),
        'w_mo': nrm((DEPTH, MEM_WIDTH, D_MODEL), BETA * MEM_WIDTH ** -0.5),
        'ln2_g': 1.0 + nrm((DEPTH, D_MODEL), 0.01),
        'ln2_b': nrm((DEPTH, D_MODEL), 0.01),
        'w_up': nrm((DEPTH, D_MODEL, 2 * D_FF), D_MODEL ** -0.5),
        'w_conv': nrm((DEPTH, CONV_W, D_FF), CONV_W ** -0.5),
        'b_conv': nrm((DEPTH, D_FF), 0.01),
        'w_down': nrm((DEPTH, D_FF, D_MODEL), BETA * D_FF ** -0.5),
        'ln3_g': 1.0 + nrm((DEPTH, D_MODEL), 0.01),
        'ln3_b': nrm((DEPTH, D_MODEL), 0.01),
    }


def reference(x_prompt, x_sample, cache_a_k, cache_a_v, cache_b_k, cache_b_v, cache_b_kidx,
              cache_mem_k, cache_mem_v, state_ffn_conv, mem_prompt, w_in, a_rel_bias, t5_bias,
              w_o, ln1_g, ln1_b, w_mq, w_mk, w_mv, w_mo, ln2_g, ln2_b, w_up, w_conv, b_conv,
              w_down, ln3_g, ln3_b):
    xp, xs = x_prompt, x_sample
    b_p, t_p = xp.shape[:2]
    s_len = xs.shape[1]
    a_keep = min(N_PREV_CHUNKS * CHUNK, t_p)
    new_p = [[] for _ in range(8)]
    new_s = [[] for _ in range(6)]
    for l in range(DEPTH):
        qa, ka, va, qb, kb, vb, qi, ki, wi = split_in(xp @ w_in[l])
        mix = jnp.concatenate([band_attend_prompt(qa, ka, va, a_rel_bias[l]),
                               dsa_prompt(qb, kb, vb, qi, ki, wi, t5_bias)], axis=-1)
        h = layer_norm(ALPHA * xp + mix @ w_o[l], ln1_g[l], ln1_b[l])
        mk, mv = mem_kv(mem_prompt, w_mk[l], w_mv[l])
        h = layer_norm(ALPHA * h + mem_attend(h, mk, mv, w_mq[l], w_mo[l]), ln2_g[l], ln2_b[l])
        f, g_tail = conv_ffn(h, jnp.zeros((b_p, CONV_W - 1, D_FF), h.dtype), w_up[l], w_conv[l], b_conv[l], w_down[l])
        xp = layer_norm(ALPHA * h + f, ln3_g[l], ln3_b[l])
        for lst, arr in zip(new_p, (ka[:, t_p - a_keep:], va[:, t_p - a_keep:], kb, vb, ki, mk, mv, g_tail)):
            lst.append(arr)

        qa, ka, va, qb, kb, vb, qi, ki, wi = split_in(xs @ w_in[l])
        oa = band_attend_sample(qa, jnp.concatenate([cache_a_k[l], ka], axis=1),
                                jnp.concatenate([cache_a_v[l], va], axis=1), a_rel_bias[l])
        kb_all = jnp.concatenate([cache_b_k[l], kb], axis=1)
        vb_all = jnp.concatenate([cache_b_v[l], vb], axis=1)
        ki_all = jnp.concatenate([cache_b_kidx[l], ki], axis=1)
        n_keys = kb_all.shape[1]
        qpos = n_keys - s_len + jnp.arange(s_len)
        adm = jnp.ones((s_len, n_keys), dtype=bool)
        ob = dsa_attend(qb, qi, wi, qpos, kb_all, vb_all, ki_all, adm, min(TOPK_MAX, n_keys // 4), t5_bias)
        h = layer_norm(ALPHA * xs + jnp.concatenate([oa, ob], axis=-1) @ w_o[l], ln1_g[l], ln1_b[l])
        h = layer_norm(ALPHA * h + mem_attend(h, cache_mem_k[l], cache_mem_v[l], w_mq[l], w_mo[l]), ln2_g[l], ln2_b[l])
        f, g_tail_s = conv_ffn(h, state_ffn_conv[l], w_up[l], w_conv[l], b_conv[l], w_down[l])
        xs = layer_norm(ALPHA * h + f, ln3_g[l], ln3_b[l])
        for lst, arr in zip(new_s, (ka, va, kb, vb, ki, g_tail_s)):
            lst.append(arr)

    pak, pav, pbk, pbv, pbi, pmk, pmv, pfc = [jnp.stack(a) for a in new_p]
    sak, sav, sbk, sbv, sbi, sfc = [jnp.stack(a) for a in new_s]
    return (xp, xs, pak, pav, pbk, pbv, pbi, pmk, pmv, pfc, sak, sav, sbk, sbv, sbi, sfc)
```

```cpp
#define MK_N_LAUNCHES 1
#include <hip/hip_runtime.h>
#include <cstdio>
#include <cstdint>

#define GAS __attribute__((address_space(1)))
#define LAS __attribute__((address_space(3)))
typedef unsigned short bf16;
typedef short bf16x8 __attribute__((ext_vector_type(8)));
typedef short s16x4 __attribute__((ext_vector_type(4)));
typedef float f32x4 __attribute__((ext_vector_type(4)));
typedef float f32x2 __attribute__((ext_vector_type(2)));
typedef unsigned u32x4 __attribute__((ext_vector_type(4)));
typedef unsigned u32x2 __attribute__((ext_vector_type(2)));
typedef GAS unsigned gu32;

constexpr int D = 1024, NBATCH = 4, SEQ = 4096, MP = NBATCH * SEQ;
constexpr int DB = 8, DS = 16, MS = DB * DS, PAST = 2048;
constexpr int MROWS = MP + MS;
constexpr int MT = MP + 256;
constexpr int DFF = 2816, NUP = 2 * DFF;
constexpr int AKS = 528;
constexpr int BKS = PAST + DS;
constexpr int NMAIN = 2560;
constexpr float ALPHA = 1.189207115002721f;
constexpr float LN_EPS = 1e-5f;
constexpr float LOG2E = 1.4426950408889634f;
constexpr float QSCALE = 0.125f * LOG2E;
constexpr float QMSCALE = 0.08838834764831845f * LOG2E;
constexpr float WISCALE = 0.35355339059327373f * 0.125f;

enum { I_XP = 0, I_XS, I_CAK, I_CAV, I_CBK, I_CBV, I_CBI, I_CMK, I_CMV, I_FFN, I_MEM, I_WIN, I_AREL, I_T5, I_WO, I_G1, I_B1, I_WMQ, I_WMK, I_WMV, I_WMO, I_G2, I_B2,
       I_WUP, I_WCONV, I_BCONV, I_WDN, I_G3, I_B3, N_IN };

constexpr size_t O_YP = 0;
constexpr size_t O_YS = O_YP + (size_t)MP * D;
constexpr size_t O_PAK = O_YS + (size_t)MS * D;
constexpr size_t O_PAV = O_PAK + (size_t)NBATCH * 512 * 512;
constexpr size_t O_PBK = O_PAV + (size_t)NBATCH * 512 * 512;
constexpr size_t O_PBV = O_PBK + (size_t)MP * 128;
constexpr size_t O_PBI = O_PBV + (size_t)MP * 128;
constexpr size_t O_PMK = O_PBI + (size_t)MP * 64;
constexpr size_t O_PMV = O_PMK + (size_t)NBATCH * 256 * 512;
constexpr size_t O_PFC = O_PMV + (size_t)NBATCH * 256 * 512;
constexpr size_t O_SAK = O_PFC + (size_t)NBATCH * 2 * DFF;
constexpr size_t O_SAV = O_SAK + (size_t)MS * 512;
constexpr size_t O_SBK = O_SAV + (size_t)MS * 512;
constexpr size_t O_SBV = O_SBK + (size_t)MS * 128;
constexpr size_t O_SBI = O_SBV + (size_t)MS * 128;
constexpr size_t O_SFC = O_SBI + (size_t)MS * 64;
constexpr size_t O_END = O_SFC + (size_t)DB * 2 * DFF;
static_assert(O_END == 25536512, "output size");

constexpr size_t MiB = 1u << 20;
constexpr size_t WS_CTL = 0, CTL_ZERO_BYTES = 1 * MiB;
constexpr size_t WS_WIN = 1 * MiB;
constexpr size_t WS_WVA = 6 * MiB;
constexpr size_t WS_WO = 7 * MiB;
constexpr size_t WS_WMQ = 9 * MiB;
constexpr size_t WS_WMK = 10 * MiB;
constexpr size_t WS_WMV = 11 * MiB;
constexpr size_t WS_WMO = 12 * MiB;
constexpr size_t WS_WUP = 13 * MiB;
constexpr size_t WS_WDN = 24 * MiB;
constexpr size_t WS_AB = 31 * MiB;
constexpr size_t WS_MEMB = 64 * MiB;
constexpr size_t WS_MK = 66 * MiB;
constexpr size_t WS_MVT = 67 * MiB;
constexpr size_t WS_MKS = 68 * MiB;
constexpr size_t WS_MVTS = 70 * MiB;
constexpr size_t WS_QM = 72 * MiB;
constexpr size_t WS_WI = 89 * MiB;
constexpr size_t WS_Q2 = 90 * MiB;
constexpr size_t WS_KA = 123 * MiB;
constexpr size_t WS_VAT = 139 * MiB;
constexpr size_t WS_QI = 155 * MiB;
constexpr size_t WS_KB = 172 * MiB;
constexpr size_t WS_VB = 176 * MiB;
constexpr size_t WS_KI = 180 * MiB;
constexpr size_t WS_KAS = 182 * MiB;
constexpr size_t WS_VATS = 187 * MiB;
constexpr size_t WS_KBS = 192 * MiB;
constexpr size_t WS_VBS = 197 * MiB;
constexpr size_t WS_KIS = 202 * MiB;
constexpr size_t WS_HMID = 90 * MiB;
constexpr size_t WS_END = 206 * MiB;
static_assert(WS_HMID + (size_t)MT * DFF * 2 <= WS_KAS, "hmid overlay");
static_assert(WS_AB + (size_t)MT * D * 2 <= WS_MEMB && WS_QM + (size_t)MT * 512 * 2 <= WS_WI && WS_WI + (size_t)MT * 32 <= WS_Q2 && WS_Q2 + (size_t)MT * D * 2 <= WS_KA, "ws map");
static_assert(WS_QI + (size_t)MT * 512 * 2 <= WS_KB && WS_KAS + (size_t)(8 * AKS + 32) * 1024 <= WS_VATS && WS_VATS + (size_t)8 * 512 * AKS * 2 + 64 <= WS_KBS && WS_KBS + (size_t)8 * BKS * 256 <= WS_VBS && WS_KIS + (size_t)8 * BKS * 128 <= WS_END, "ws map 2");
constexpr int CW_TMO = 0, CW_CODE = 1, CW_BAR = 4096;
constexpr size_t CT_CSQ = 64 * 1024;
constexpr size_t CT_BQ = CT_CSQ + 2048;
constexpr size_t CT_CSU = 72 * 1024;
constexpr size_t CT_BU = 96 * 1024;
constexpr size_t CT_ST1 = 128 * 1024;
constexpr size_t CT_ST2 = 384 * 1024;
static_assert(CT_ST1 + (size_t)MT * 8 <= CT_ST2 && CT_ST2 + (size_t)MT * 8 <= CTL_ZERO_BYTES, "ctl map");

constexpr int RING_BYTES = 131072;
constexpr int SC_STRIDE = 8200;
constexpr int L_SEL = 131328;
constexpr int L_T5 = L_SEL + 16384;
constexpr int L_LUT = L_T5 + 1024;
constexpr int L_ABIAS = L_LUT + 256;
constexpr int L_XG = L_ABIAS + 6144;
constexpr int L_MISC = L_XG + 4096;
constexpr int LDS_BYTES = 163840;
static_assert(16 * SC_STRIDE <= L_SEL && L_MISC + 512 <= LDS_BYTES, "LDS map");

constexpr int NWAVES = 8;
#ifndef MK_N_LAUNCHES
#define MK_N_LAUNCHES 1
#endif
constexpr int N_PHASES = 10;
namespace pg8 {
#define PG8_LAS __attribute__((address_space(3)))
typedef unsigned short bf16_t;
constexpr int BM = 256, BK = 64, HALF = 128, HTB = HALF * BK * 2  , STAGE_BYTES = 8 * HTB, NXCD = 8, WGM = 8;
__host__ __device__ __forceinline__ int lds_byte(int r, int c) { const int st = (r >> 4) * 2 + (c >> 5), rr = r & 15, cc = c & 31, ob = rr * 64 + cc * 2; return st * 1024 + (ob ^ (((ob >> 9) & 1) << 5)); }
__host__ __device__ __forceinline__ void stage_rc(int b, int& R, int& C) { const int st = b / 1024, sb = b % 1024, swz = sb ^ (((sb >> 9) & 1) << 5); R = (st >> 1) * 16 + swz / 64; C = (st & 1) * 32 + (swz % 64) / 2; }
__host__ __device__ __forceinline__ int perm32(int rho) { const int n = rho >> 4, i = rho & 15; return 8 * (i >> 2) + 4 * n + (i & 3); }
struct Unit { int pm, pn, gid; };
__device__ __forceinline__ void tile_map(int L, int nM, int nN, int& pm, int& pn) {
    const int nwg = nM * nN; int wgid = L; { const int q = nwg / NXCD, r = nwg % NXCD, xcd = wgid % NXCD, off = wgid / NXCD; wgid = (xcd < r ? xcd * (q + 1) : r * (q + 1) + (xcd - r) * q) + off; }
    const int nig = WGM * nN, gid = wgid / nig, fm = gid * WGM, gsz = (nM - fm) < WGM ? (nM - fm) : WGM;
    pm = fm + ((wgid % nig) % gsz); pn = (wgid % nig) / gsz;
}
template <class Epi, class Sched, bool ALIGN_EPI = false, bool SP2 = false>
__device__ __forceinline__ void gemm_phase(PG8_LAS unsigned char* lds, const int K_, const Sched& S, const Epi& E) {
    const int tid = threadIdx.x, wid = __builtin_amdgcn_readfirstlane(tid >> 6), lane = tid & 63, wr = wid >> 2, wc = wid & 3, fr = lane & 15, fq = lane >> 4;
    const int K = K_, nt = K / BK;
    unsigned voffA[2], voffB[2];
#pragma unroll
    for (int i = 0; i < 2; ++i) { int R, C; stage_rc(tid * 16 + i * 8192, R, C); const int Rb = Epi::PERM ? ((R & ~31) + perm32(R & 31)) : R;
        voffA[i] = (unsigned)(R * K + C) * 2u; voffB[i] = (unsigned)(Rb * K + C) * 2u; }
    const size_t kstep = (size_t)(BK * 2);
    const size_t hstep = (size_t)HALF * K * 2;
    const unsigned ldsw = (unsigned)wid * 1024u;
    const int aoff = lds_byte(wr * 64 + fr, fq * 8), boff = lds_byte(wc * 32 + fr, fq * 8);
#define PG8_SA(b, h) (((b) * 2 + (h)) * HTB)
#define PG8_SB(b, h) ((4 + (b) * 2 + (h)) * HTB)
#define PG8_STAGE(bufoff, gbase, voff) do { _Pragma("unroll") for (int _i = 0; _i < 2; ++_i) \
        __builtin_amdgcn_global_load_lds((const unsigned*)((const char*)(gbase) + (voff)[_i]), (PG8_LAS unsigned*)(lds + (bufoff) + ldsw + _i * 8192), 16, 0, 0); } while (0)
#define PG8_LDA(dst, b, h) do { _Pragma("unroll") for (int m = 0; m < 4; ++m) _Pragma("unroll") for (int k = 0; k < 2; ++k) dst[m][k] = *(const PG8_LAS bf16x8*)(lds + PG8_SA(b, h) + aoff + m * 2048 + k * 1024); } while (0)
#define PG8_LDB(dst, b, h) do { _Pragma("unroll") for (int n = 0; n < 2; ++n) _Pragma("unroll") for (int k = 0; k < 2; ++k) dst[n][k] = *(const PG8_LAS bf16x8*)(lds + PG8_SB(b, h) + boff + n * 2048 + k * 1024); } while (0)
#define PG8_MMA(ai, bj, At, Bt) do { __builtin_amdgcn_s_setprio(1); _Pragma("unroll") for (int m = 0; m < 4; ++m) _Pragma("unroll") for (int n = 0; n < 2; ++n) _Pragma("unroll") for (int k = 0; k < 2; ++k) \
        acc[ai][bj][m][n] = __builtin_amdgcn_mfma_f32_16x16x32_bf16(Bt[n][k], At[m][k], acc[ai][bj][m][n], 0, 0, 0); __builtin_amdgcn_s_setprio(0); } while (0)
#define PG8_WAIT_V(n) asm volatile("s_waitcnt vmcnt(" #n ")" ::: "memory")
#define PG8_WAIT_L(n) asm volatile("s_waitcnt lgkmcnt(" #n ")" ::: "memory")
#define PG8_BAR __builtin_amdgcn_s_barrier()
#define PG8_SCHED __builtin_amdgcn_sched_barrier(0)
    Unit cur, nxt; int ui = 0;
    if (!S.next(0, cur)) return;
    f32x4 acc[2][2][4][2];
#pragma unroll
    for (int a = 0; a < 2; ++a)
#pragma unroll
        for (int b = 0; b < 2; ++b)
#pragma unroll
            for (int m = 0; m < 4; ++m)
#pragma unroll
                for (int n = 0; n < 2; ++n) acc[a][b][m][n] = (f32x4){0.f, 0.f, 0.f, 0.f};
    bf16x8 At[4][2], B0[2][2], B1[2][2];
    const char* cA; const char* cB; S.ptrs(cur, cA, cB);
    S.a_ready(cur);
    if constexpr (SP2) {
        PG8_STAGE(PG8_SB(0, 0), cB, voffB); PG8_STAGE(PG8_SB(0, 1), cB + hstep, voffB); PG8_STAGE(PG8_SA(0, 0), cA, voffA); PG8_STAGE(PG8_SA(0, 1), cA + hstep, voffA);
        if (wr == 1) PG8_BAR;
        PG8_WAIT_V(2); PG8_BAR;
        PG8_STAGE(PG8_SB(1, 0), cB + kstep, voffB); PG8_STAGE(PG8_SA(1, 0), cA + kstep, voffA); PG8_STAGE(PG8_SB(1, 1), cB + hstep + kstep, voffB);
        PG8_WAIT_V(6); PG8_BAR;
    } else {
        PG8_STAGE(PG8_SB(0, 0), cB, voffB); PG8_STAGE(PG8_SA(0, 0), cA, voffA); PG8_STAGE(PG8_SB(0, 1), cB + hstep, voffB); PG8_STAGE(PG8_SA(0, 1), cA + hstep, voffA);
        if (wr == 1) PG8_BAR;
        PG8_WAIT_V(4); PG8_BAR;
        PG8_STAGE(PG8_SB(1, 0), cB + kstep, voffB); PG8_STAGE(PG8_SA(1, 0), cA + kstep, voffA); PG8_STAGE(PG8_SB(1, 1), cB + hstep + kstep, voffB);
        PG8_WAIT_V(6); PG8_BAR;
    }
    for (;;) {
        const bool has_next = S.next(ui + 1, nxt);
        const char* nA = cA; const char* nB = cB; if (has_next) S.ptrs(nxt, nA, nB);
        for (int t = 0; t < nt; t += 2) {
            const bool last = (t == nt - 2);
            const char* a1 = cA + (size_t)(t + 1) * kstep;
            const char* a2 = last ? nA : cA + (size_t)(t + 2) * kstep; const char* b2 = last ? nB : cB + (size_t)(t + 2) * kstep;
            const char* a3 = a2 + kstep; const char* b3 = b2 + kstep;
            if (last && has_next) S.a_ready(nxt);
            if constexpr (SP2) {
            PG8_LDB(B0, 0, 0); PG8_LDB(B1, 0, 1); PG8_SCHED; PG8_LDA(At, 0, 0); PG8_STAGE(PG8_SA(1, 1), a1 + hstep, voffA);
            PG8_WAIT_V(8); PG8_WAIT_L(0); PG8_BAR; PG8_MMA(0, 0, At, B0); PG8_MMA(0, 1, At, B1); PG8_BAR; PG8_SCHED;
            PG8_LDA(At, 0, 1); PG8_STAGE(PG8_SB(0, 0), b2, voffB); PG8_STAGE(PG8_SB(0, 1), b2 + hstep, voffB); PG8_STAGE(PG8_SA(0, 0), a2, voffA);
            PG8_WAIT_V(8); PG8_WAIT_L(0); PG8_BAR; PG8_MMA(1, 0, At, B0); PG8_MMA(1, 1, At, B1); PG8_BAR; PG8_SCHED;
            PG8_LDB(B0, 1, 0); PG8_LDB(B1, 1, 1); PG8_SCHED; PG8_LDA(At, 1, 0); PG8_STAGE(PG8_SA(0, 1), a2 + hstep, voffA);
            PG8_WAIT_V(8); PG8_WAIT_L(0); PG8_BAR; PG8_MMA(0, 0, At, B0); PG8_MMA(0, 1, At, B1); PG8_BAR; PG8_SCHED;
            PG8_LDA(At, 1, 1); PG8_STAGE(PG8_SB(1, 0), b3, voffB); PG8_STAGE(PG8_SB(1, 1), b3 + hstep, voffB); PG8_STAGE(PG8_SA(1, 0), a3, voffA);
            PG8_WAIT_V(8); PG8_WAIT_L(0); PG8_BAR; PG8_MMA(1, 0, At, B0); PG8_MMA(1, 1, At, B1); PG8_BAR; PG8_SCHED;
            } else {
            PG8_LDB(B0, 0, 0); PG8_SCHED; PG8_LDA(At, 0, 0); PG8_STAGE(PG8_SA(1, 1), a1 + hstep, voffA);
            PG8_WAIT_L(8); PG8_BAR; PG8_WAIT_L(0); PG8_MMA(0, 0, At, B0); PG8_BAR; PG8_SCHED;
            PG8_LDB(B1, 0, 1); PG8_STAGE(PG8_SB(0, 0), b2, voffB);
            PG8_BAR; PG8_WAIT_L(0); PG8_MMA(0, 1, At, B1); PG8_BAR;
            PG8_LDA(At, 0, 1); PG8_STAGE(PG8_SA(0, 0), a2, voffA);
            PG8_BAR; PG8_WAIT_L(0); PG8_MMA(1, 0, At, B0); PG8_BAR; PG8_SCHED;
            PG8_STAGE(PG8_SB(0, 1), b2 + hstep, voffB);
            PG8_WAIT_V(6); PG8_BAR; PG8_MMA(1, 1, At, B1); PG8_BAR;
            PG8_LDB(B0, 1, 0); PG8_SCHED; PG8_LDA(At, 1, 0); PG8_STAGE(PG8_SA(0, 1), a2 + hstep, voffA);
            PG8_WAIT_L(8); PG8_BAR; PG8_WAIT_L(0); PG8_MMA(0, 0, At, B0); PG8_BAR; PG8_SCHED;
            PG8_LDB(B1, 1, 1); PG8_STAGE(PG8_SB(1, 0), b3, voffB);
            PG8_BAR; PG8_WAIT_L(0); PG8_MMA(0, 1, At, B1); PG8_BAR;
            PG8_LDA(At, 1, 1); PG8_STAGE(PG8_SA(1, 0), a3, voffA);
            PG8_BAR; PG8_WAIT_L(0); PG8_MMA(1, 0, At, B0); PG8_BAR; PG8_SCHED;
            PG8_STAGE(PG8_SB(1, 1), b3 + hstep, voffB);
            PG8_WAIT_V(6); PG8_BAR; PG8_MMA(1, 1, At, B1); PG8_BAR;
            }
        }
        if constexpr (ALIGN_EPI) { if (wr == 0) PG8_BAR; }
        if constexpr (!Epi::AFTER_DRAIN) { E(acc, cur, wr, wc, fr, fq, lane); S.done(cur); }
        if (!has_next) break;
#pragma unroll
        for (int a = 0; a < 2; ++a)
#pragma unroll
            for (int b = 0; b < 2; ++b)
#pragma unroll
                for (int m = 0; m < 4; ++m)
#pragma unroll
                    for (int n = 0; n < 2; ++n) acc[a][b][m][n] = (f32x4){0.f, 0.f, 0.f, 0.f};
        cur = nxt; cA = nA; cB = nB; ++ui;
        if constexpr (ALIGN_EPI) { if (wr == 1) PG8_BAR; }
    }
    PG8_WAIT_V(0);
    if constexpr (!ALIGN_EPI) { if (wr == 0) PG8_BAR; }
    PG8_BAR;
    if constexpr (Epi::AFTER_DRAIN) { E.fused(acc, cur, wr, wc, fr, fq, lds, wid, lane); S.done(cur); }
#undef PG8_SA
#undef PG8_SB
#undef PG8_STAGE
#undef PG8_LDA
#undef PG8_LDB
#undef PG8_MMA
#undef PG8_WAIT_V
#undef PG8_WAIT_L
#undef PG8_BAR
#undef PG8_SCHED
}}
#define RLX_AGENT __ATOMIC_RELAXED, __HIP_MEMORY_SCOPE_AGENT
#define LDS_WAIT() asm volatile("s_waitcnt lgkmcnt(0)" ::: "memory")
#define VM_WAIT() asm volatile("s_waitcnt vmcnt(0)" ::: "memory")
__device__ __forceinline__ unsigned long long rt() { return __builtin_amdgcn_s_memrealtime(); }
__device__ __forceinline__ unsigned f2bf(float f) { unsigned u = __builtin_bit_cast(unsigned, f); return (u + 0x7fffu + ((u >> 16) & 1u)) >> 16; }
__device__ __forceinline__ unsigned pk2(float lo, float hi) { return f2bf(lo) | (f2bf(hi) << 16); }
#define XB_TMO      128
#define XB_XCNT(j)  (256  + 64 * (j))
#define XB_XSUB(j)  (1280 + 64 * (j))
#define XB_XGEN(j)  (2304 + 64 * (j))
#define XB_TOP      3328
#define XB_TOPGEN   3392
#define XCD_BAR_WORDS 3456
#define XB_SPIN_CAP (1u << 18)

__device__ __forceinline__ unsigned xb_ld(unsigned* p)              { return __hip_atomic_load(p, __ATOMIC_RELAXED, __HIP_MEMORY_SCOPE_AGENT); }
__device__ __forceinline__ unsigned xb_add(unsigned* p, unsigned v) { return __hip_atomic_fetch_add(p, v, __ATOMIC_RELAXED, __HIP_MEMORY_SCOPE_AGENT); }
__device__ __forceinline__ unsigned xb_xcc_id() { return (unsigned)__builtin_amdgcn_s_getreg((3 << 11) | 20) & 0xFu; }
#define XB_SPIN(cond, bar) do { unsigned _sp = 0; while (cond) { __builtin_amdgcn_s_sleep(1); \
    if ((++_sp & 255u) == 0u) { if (xb_ld(&(bar)[XB_TMO])) break; if (_sp > XB_SPIN_CAP) { atomicAdd(&(bar)[XB_TMO], 1u); break; } } } } while (0)

struct XcdBarrier {
    unsigned* bar; unsigned x;
    volatile LAS unsigned* st;
};

__device__ __forceinline__ XcdBarrier xcd_barrier_post(unsigned* bar, volatile LAS unsigned* st) {
    XcdBarrier b; b.bar = bar; b.x = xb_xcc_id(); b.st = st;
    if (threadIdx.x == 0) (void)xb_add(&bar[XB_XCNT(b.x)], 1u);
    return b;
}
__device__ __forceinline__ void xcd_barrier_complete(unsigned* bar, unsigned x, unsigned& nloc, unsigned& nx) {
    const unsigned G = gridDim.x * gridDim.y * gridDim.z;
    unsigned sum, cnt, mine, sp = 0u;
    for (;;) {
        sum = 0u; cnt = 0u; mine = 0u;
#pragma unroll
        for (unsigned j = 0; j < 16; ++j) { const unsigned c = xb_ld(&bar[XB_XCNT(j)]); sum += c; cnt += (c > 0u) ? 1u : 0u; mine = (j == x) ? c : mine; }
        if (sum == G) break;
        __builtin_amdgcn_s_sleep(1);
        if ((++sp & 255u) == 0u) { if (xb_ld(&bar[XB_TMO])) break; if (sp > XB_SPIN_CAP) { atomicAdd(&bar[XB_TMO], 1u); break; } }
    }
    nloc = mine > 0u ? mine : 1u; nx = cnt > 0u ? cnt : 1u;
}

__device__ __forceinline__ void xcd_barrier(const XcdBarrier& b) {
    asm volatile("s_waitcnt vmcnt(0)" ::: "memory");
    __syncthreads();
    if (threadIdx.x == 0) {
        unsigned* bar = b.bar;
        __builtin_amdgcn_s_waitcnt(0);
        unsigned nloc = b.st[0], nx = b.st[1];
        if (nloc == 0u) { xcd_barrier_complete(bar, b.x, nloc, nx); b.st[0] = nloc; b.st[1] = nx; }
        const unsigned old = xb_add(&bar[XB_XSUB(b.x)], 1u);
        const unsigned gen = old / nloc;
        if (old + 1u == (gen + 1u) * nloc) {
            __builtin_amdgcn_fence(__ATOMIC_RELEASE, "agent");
            asm volatile("s_waitcnt vmcnt(0)" ::: "memory");
            const unsigned og = xb_add(&bar[XB_TOP], 1u);
            const unsigned tg = og / nx;
            if (og + 1u == (tg + 1u) * nx) xb_add(&bar[XB_TOPGEN], 1u);
            else XB_SPIN(xb_ld(&bar[XB_TOPGEN]) == tg, bar);
            __builtin_amdgcn_fence(__ATOMIC_ACQUIRE, "agent");
            xb_add(&bar[XB_XGEN(b.x)], 1u);
            asm volatile("s_waitcnt vmcnt(0)" ::: "memory");
        } else {
            XB_SPIN(xb_ld(&bar[XB_XGEN(b.x)]) == gen, bar);
            __builtin_amdgcn_fence(__ATOMIC_ACQUIRE, "agent");
            asm volatile("s_waitcnt vmcnt(0)" ::: "memory");
        }
    }
    __syncthreads();
}
typedef __bf16 bf16x2_t __attribute__((ext_vector_type(2)));
__device__ __forceinline__ unsigned cvtpk(float lo, float hi) { f32x2 v = {lo, hi}; bf16x2_t b = __builtin_convertvector(v, bf16x2_t); return __builtin_bit_cast(unsigned, b); }
__device__ __forceinline__ float bf2f(short x) { return __uint_as_float(((unsigned)(unsigned short)x) << 16); }
__device__ __forceinline__ void st_bf16x4(bf16* p, f32x4 v) { u32x2 w; w.x = cvtpk(v[0], v[1]); w.y = cvtpk(v[2], v[3]); *(u32x2*)p = w; }
__device__ __forceinline__ bf16x8 pack8(f32x4 a, f32x4 b) { u32x4 w; w.x = cvtpk(a[0], a[1]); w.y = cvtpk(a[2], a[3]); w.z = cvtpk(b[0], b[1]); w.w = cvtpk(b[2], b[3]); return __builtin_bit_cast(bf16x8, w); }
#define MFMA16(a, b, c) __builtin_amdgcn_mfma_f32_16x16x32_bf16((a), (b), (c), 0, 0, 0)
__device__ __forceinline__ float xor16(float v) { return __shfl_xor(v, 16); }
__device__ __forceinline__ float xor32(float v) { return __shfl_xor(v, 32); }
__device__ __forceinline__ float ror1(float v) { return __int_as_float(__builtin_amdgcn_update_dpp(0, __float_as_int(v), 0x121, 0xf, 0xf, false)); }
__device__ __forceinline__ float ror2(float v) { return __int_as_float(__builtin_amdgcn_update_dpp(0, __float_as_int(v), 0x122, 0xf, 0xf, false)); }
__device__ __forceinline__ float gelu_tanh(float x) { const float e = __builtin_amdgcn_exp2f(-2.3022081985f * (x + 0.044715f * x * x * x)); return x * __builtin_amdgcn_rcpf(1.0f + e); }
__device__ __forceinline__ s16x4 tr_read(const LAS unsigned char* p) { return __builtin_bit_cast(s16x4, __builtin_amdgcn_ds_read_tr16_b64_v4i16((LAS s16x4*)p)); }

struct Frame {
    LAS unsigned char* lds;
    volatile LAS unsigned* MISC;
    gu32* ctl;
    unsigned char* ws;
    const float* const* in;
    float* out;
    int tid, lane, wave, vcu, G;
};

__device__ __forceinline__ void tr_item(const float* W, int ldw, int n0, int nvalid, int k0, const float* ksc, bf16* dst, size_t dpitch, int drow, LAS float* scr, int lane) {
#pragma unroll 8
    for (int i = 0; i < 32; ++i) { const int kk = 2 * i + (lane >> 5), n = n0 + (lane & 31);
        float v = (n < nvalid) ? W[(size_t)(k0 + kk) * ldw + n] : 0.f; if (ksc) v *= ksc[k0 + kk];
        scr[kk * 33 + (lane & 31)] = v; }
    LDS_WAIT(); asm volatile("" ::: "memory");
    const int c = lane & 7;
#pragma unroll
    for (int j = 0; j < 4; ++j) { const int n = (lane >> 3) + 8 * j; const LAS float* s = scr + (8 * c) * 33 + n;
        u32x4 o; o.x = cvtpk(s[0 * 33], s[1 * 33]); o.y = cvtpk(s[2 * 33], s[3 * 33]); o.z = cvtpk(s[4 * 33], s[5 * 33]); o.w = cvtpk(s[6 * 33], s[7 * 33]);
        *(u32x4*)(dst + (size_t)(drow + n) * dpitch + k0 + 8 * c) = o; }
    LDS_WAIT(); asm volatile("" ::: "memory");
}
__device__ __forceinline__ void cvt_seg(const float* src, bf16* dst, size_t total, size_t sb, size_t db, int gw, int NGW, int lane) {
    const size_t nit = total / 512;
    for (size_t it = gw; it < nit; it += NGW) { const size_t e = it * 512 + lane * 8; const f32x4 a = *(const f32x4*)(src + e), b = *(const f32x4*)(src + e + 4);
        u32x4 o; o.x = cvtpk(a[0], a[1]); o.y = cvtpk(a[2], a[3]); o.z = cvtpk(b[0], b[1]); o.w = cvtpk(b[2], b[3]);
        *(u32x4*)(dst + (e / sb) * db + (e % sb)) = o; }
}
__device__ __forceinline__ void csum_item(const float* W, int ldw, int n, int k0, const float* gk, const float* bk, float* cs, float* bv, int dest) {
    float s1 = 0.f, s2 = 0.f;
#pragma unroll 8
    for (int k = 0; k < 128; ++k) { const float w = W[(size_t)(k0 + k) * ldw + n]; s1 += __uint_as_float(f2bf(gk[k0 + k] * w) << 16); s2 += bk[k0 + k] * w; }
    atomicAdd(cs + dest, s1); atomicAdd(bv + dest, s2);
}
__device__ __forceinline__ void p0_prologue(Frame& F) {
    LAS float* scr = (LAS float*)(F.lds + F.wave * 16384);
    const int gw = F.vcu * NWAVES + F.wave, NGW = F.G * NWAVES, lane = F.lane;
    unsigned char* ws = F.ws;
    for (int it = gw; it < 16 * 91; it += NGW) { const int kb = it / 91, nb = it % 91, n0 = 32 * nb; bf16* dst = (bf16*)(ws + WS_WIN); int drow;
        if (n0 < 512) drow = n0; else if (n0 < 1024) drow = 1024 + (n0 - 512); else if (n0 < 1536) { dst = (bf16*)(ws + WS_WVA); drow = n0 - 1024; } else if (n0 < 2048) drow = 512 + (n0 - 1536);
        else if (n0 < 2304) drow = n0; else if (n0 < 2816) drow = 1536 + (n0 - 2304); else drow = 2304 + (n0 - 2816);
        tr_item(F.in[I_WIN], 2888, n0, 2888, 64 * kb, nullptr, dst, 1024, drow, scr, lane); }
    for (int it = gw; it < 320; it += NGW) *(u32x4*)(ws + WS_WIN + (size_t)2400 * 2048 + (size_t)it * 1024 + lane * 16) = (u32x4){0u, 0u, 0u, 0u};
    for (int it = gw; it < 16 * 32; it += NGW) tr_item(F.in[I_WO], 1024, 32 * (it % 32), 1024, 64 * (it / 32), nullptr, (bf16*)(ws + WS_WO), 1024, 32 * (it % 32), scr, lane);
    for (int it = gw; it < 16 * 16; it += NGW) tr_item(F.in[I_WMQ], 512, 32 * (it % 16), 512, 64 * (it / 16), F.in[I_G1], (bf16*)(ws + WS_WMQ), 1024, 32 * (it % 16), scr, lane);
    for (int it = gw; it < 16 * 16; it += NGW) tr_item(F.in[I_WMK], 512, 32 * (it % 16), 512, 64 * (it / 16), nullptr, (bf16*)(ws + WS_WMK), 1024, 32 * (it % 16), scr, lane);
    for (int it = gw; it < 16 * 16; it += NGW) tr_item(F.in[I_WMV], 512, 32 * (it % 16), 512, 64 * (it / 16), nullptr, (bf16*)(ws + WS_WMV), 1024, 32 * (it % 16), scr, lane);
    for (int it = gw; it < 8 * 32; it += NGW) tr_item(F.in[I_WMO], 1024, 32 * (it % 32), 1024, 64 * (it / 32), nullptr, (bf16*)(ws + WS_WMO), 512, 32 * (it % 32), scr, lane);
    for (int it = gw; it < 16 * 176; it += NGW) { const int kb = it / 176, n0 = 32 * (it % 176); const int nn = n0 < DFF ? n0 : n0 - DFF; const int drow = 256 * (nn / 128) + (nn % 128) + (n0 < DFF ? 0 : 128);
        tr_item(F.in[I_WUP], NUP, n0, NUP, 64 * kb, F.in[I_G2], (bf16*)(ws + WS_WUP), 1024, drow, scr, lane); }
    for (int it = gw; it < 44 * 32; it += NGW) tr_item(F.in[I_WDN], 1024, 32 * (it % 32), 1024, 64 * (it / 32), nullptr, (bf16*)(ws + WS_WDN), DFF, 32 * (it % 32), scr, lane);
    for (int it = gw; it < 8 * 128; it += NGW) { const int sb = it / 128, r = it % 128;
        tr_item(F.in[I_CAV] + (size_t)sb * 512 * 512, 512, 32 * (r % 16), 512, 64 * (r / 16), nullptr, (bf16*)(ws + WS_VATS) + (size_t)sb * 512 * AKS, AKS, 32 * (r % 16), scr, lane); }
    for (int it = gw; it < 8 * 64; it += NGW) { const int sb = it / 64, r = it % 64;
        tr_item(F.in[I_CMV] + (size_t)sb * 256 * 512, 512, 32 * (r % 16), 512, 64 * (r / 16), nullptr, (bf16*)(ws + WS_MVTS) + (size_t)sb * 512 * 256, 256, 32 * (r % 16), scr, lane); }
    cvt_seg(F.in[I_XP], (bf16*)(ws + WS_AB), (size_t)MP * D, (size_t)MP * D, 0, gw, NGW, lane);
    cvt_seg(F.in[I_XS], (bf16*)(ws + WS_AB) + (size_t)MP * D, (size_t)MS * D, (size_t)MS * D, 0, gw, NGW, lane);
    for (int it = gw; it < 256; it += NGW) *(u32x4*)(ws + WS_AB + (size_t)MROWS * 2048 + (size_t)it * 1024 + lane * 16) = (u32x4){0u, 0u, 0u, 0u};
    cvt_seg(F.in[I_MEM], (bf16*)(ws + WS_MEMB), (size_t)1024 * 1024, (size_t)1024 * 1024, 0, gw, NGW, lane);
    cvt_seg(F.in[I_CAK], (bf16*)(ws + WS_KAS), (size_t)8 * 512 * 512, (size_t)512 * 512, (size_t)AKS * 512, gw, NGW, lane);
    cvt_seg(F.in[I_CBK], (bf16*)(ws + WS_KBS), (size_t)8 * PAST * 128, (size_t)PAST * 128, (size_t)BKS * 128, gw, NGW, lane);
    cvt_seg(F.in[I_CBV], (bf16*)(ws + WS_VBS), (size_t)8 * PAST * 128, (size_t)PAST * 128, (size_t)BKS * 128, gw, NGW, lane);
    cvt_seg(F.in[I_CBI], (bf16*)(ws + WS_KIS), (size_t)8 * PAST * 64, (size_t)PAST * 64, (size_t)BKS * 64, gw, NGW, lane);
    cvt_seg(F.in[I_CMK], (bf16*)(ws + WS_MKS), (size_t)8 * 256 * 512, (size_t)8 * 256 * 512, 0, gw, NGW, lane);
    for (int it = gw; it < 64; it += NGW) { const int n = 64 * (it % 8) + lane; csum_item(F.in[I_WMQ], 512, n, 128 * (it / 8), F.in[I_G1], F.in[I_B1], (float*)(ws + CT_CSQ), (float*)(ws + CT_BQ), n); }
    for (int it = gw; it < 704; it += NGW) { const int n = 64 * (it % 88) + lane; const int nn = n < DFF ? n : n - DFF; const int dest = 256 * (nn / 128) + (nn % 128) + (n < DFF ? 0 : 128);
        csum_item(F.in[I_WUP], NUP, n, 128 * (it / 88), F.in[I_G2], F.in[I_B2], (float*)(ws + CT_CSU), (float*)(ws + CT_BU), dest); }
}

struct SchedPlain {
    int nM, nN, G, c; const char* A; const char* B; size_t rowbytes;
    __device__ __forceinline__ bool next(int i, pg8::Unit& u) const { const long L = (long)i * G + c; if (L >= (long)nM * nN) return false; pg8::tile_map((int)L, nM, nN, u.pm, u.pn); u.gid = 0; return true; }
    __device__ __forceinline__ void ptrs(const pg8::Unit& u, const char*& a, const char*& b) const { a = A + (size_t)u.pm * 256 * rowbytes; b = B + (size_t)u.pn * 256 * rowbytes; }
    __device__ __forceinline__ void a_ready(const pg8::Unit&) const {}
    __device__ __forceinline__ void done(const pg8::Unit&) const {}
};
struct SchedP1 {
    int G, c; const char *AB, *WIN, *WVA, *MEMB, *WMK, *WMV;
    __device__ __forceinline__ bool next(int i, pg8::Unit& u) const { long L = (long)i * G + c;
        if (L < 650) { pg8::tile_map((int)L, 65, 10, u.pm, u.pn); u.gid = 0; return true; } L -= 650;
        if (L < 130) { pg8::tile_map((int)L, 2, 65, u.pm, u.pn); u.gid = 1; return true; } L -= 130;
        if (L < 8) { u.pm = (int)L & 3; u.pn = (int)L >> 2; u.gid = 2; return true; } L -= 8;
        if (L < 8) { u.pm = (int)L & 1; u.pn = (int)L >> 1; u.gid = 3; return true; }
        return false; }
    __device__ __forceinline__ void ptrs(const pg8::Unit& u, const char*& a, const char*& b) const { const size_t t = (size_t)256 * 2048;
        if (u.gid == 0) { a = AB + u.pm * t; b = WIN + u.pn * t; } else if (u.gid == 1) { a = WVA + u.pm * t; b = AB + u.pn * t; }
        else if (u.gid == 2) { a = MEMB + u.pm * t; b = WMK + u.pn * t; } else { a = WMV + u.pm * t; b = MEMB + u.pn * t; } }
    __device__ __forceinline__ void a_ready(const pg8::Unit&) const {}
    __device__ __forceinline__ void done(const pg8::Unit&) const {}
};
struct SchedP5 {
    int G, c; const char* A; const char* B;
    __device__ __forceinline__ bool next(int i, pg8::Unit& u) const { const long L = (long)i * G + c; if (L >= 66 * 22) return false; pg8::tile_map((int)L, 66, 22, u.pm, u.pn); u.gid = 0; return true; }
    __device__ __forceinline__ void ptrs(const pg8::Unit& u, const char*& a, const char*& b) const { const long R0 = u.pm < 65 ? 254L * u.pm - 2 : (long)MP; a = A + R0 * 2048; b = B + (size_t)u.pn * 256 * 2048; }
    __device__ __forceinline__ void a_ready(const pg8::Unit&) const {}
    __device__ __forceinline__ void done(const pg8::Unit&) const {}
};

#define EPI_ROWS(R0) _Pragma("unroll") for (int ai = 0; ai < 2; ++ai) _Pragma("unroll") for (int m = 0; m < 4; ++m) { const int row = (R0) + 128 * ai + 64 * wr + 16 * m + fr;
#define EPI_COLS(C0) _Pragma("unroll") for (int bj = 0; bj < 2; ++bj) _Pragma("unroll") for (int n = 0; n < 2; ++n) { const int col = (C0) + 128 * bj + 32 * wc + 16 * n + 4 * fq; const f32x4 a4 = acc[ai][bj][m][n];

struct EpiP1 {
    static constexpr bool PERM = false, AFTER_DRAIN = false;
    unsigned char* ws; float* out;
    __device__ __forceinline__ void main_elem(int row, int col, f32x4 v) const {
        const bool smp = row >= MP; const int s = row - MP, sb = s >> 4, si = s & 15, b = row >> 12, t = row & 4095;
        if (col < 1024) { st_bf16x4((bf16*)(ws + WS_Q2) + (size_t)row * 1024 + col, v * QSCALE); }
        else if (col < 1536) { const int kc = col - 1024;
            if (!smp) { st_bf16x4((bf16*)(ws + WS_KA) + (size_t)row * 512 + kc, v); if (t >= 3584) *(f32x4*)(out + O_PAK + ((size_t)(b * 512 + t - 3584) * 512 + kc)) = v; }
            else { st_bf16x4((bf16*)(ws + WS_KAS) + ((size_t)(sb * AKS + 512 + si) * 512 + kc), v); *(f32x4*)(out + O_SAK + (size_t)s * 512 + kc) = v; } }
        else if (col < 2048) { st_bf16x4((bf16*)(ws + WS_QI) + (size_t)row * 512 + (col - 1536), v); }
        else if (col < 2176) { const int c2 = col - 2048;
            if (!smp) { st_bf16x4((bf16*)(ws + WS_KB) + (size_t)row * 128 + c2, v); *(f32x4*)(out + O_PBK + (size_t)row * 128 + c2) = v; }
            else { st_bf16x4((bf16*)(ws + WS_KBS) + ((size_t)(sb * BKS + PAST + si) * 128 + c2), v); *(f32x4*)(out + O_SBK + (size_t)s * 128 + c2) = v; } }
        else if (col < 2304) { const int c2 = col - 2176;
            if (!smp) { st_bf16x4((bf16*)(ws + WS_VB) + (size_t)row * 128 + c2, v); *(f32x4*)(out + O_PBV + (size_t)row * 128 + c2) = v; }
            else { st_bf16x4((bf16*)(ws + WS_VBS) + ((size_t)(sb * BKS + PAST + si) * 128 + c2), v); *(f32x4*)(out + O_SBV + (size_t)s * 128 + c2) = v; } }
        else if (col < 2368) { const int c3 = col - 2304;
            if (!smp) { st_bf16x4((bf16*)(ws + WS_KI) + (size_t)row * 64 + c3, v); *(f32x4*)(out + O_PBI + (size_t)row * 64 + c3) = v; }
            else { st_bf16x4((bf16*)(ws + WS_KIS) + ((size_t)(sb * BKS + PAST + si) * 64 + c3), v); *(f32x4*)(out + O_SBI + (size_t)s * 64 + c3) = v; } }
        else if (col < 2376) { *(f32x4*)((float*)(ws + WS_WI) + (size_t)row * 8 + (col - 2368)) = v * WISCALE; }
    }
    __device__ __forceinline__ void operator()(const f32x4 (&acc)[2][2][4][2], const pg8::Unit& u, int wr, int wc, int fr, int fq, int lane) const {
        if (u.gid == 0) {
            EPI_ROWS(256 * u.pm) if (row < MROWS) { EPI_COLS(256 * u.pn) main_elem(row, col, a4); } } }
        } else if (u.gid == 1) {
            EPI_ROWS(256 * u.pm) EPI_COLS(256 * u.pn)
                if (col < MP) { const int b = col >> 12, t = col & 4095; st_bf16x4((bf16*)(ws + WS_VAT) + ((size_t)(b * 512 + row) * 4096 + t), a4);
                    if (t >= 3584) { float* o = out + O_PAV + ((size_t)(b * 512 + t - 3584) * 512 + row); o[0] = a4[0]; o[512] = a4[1]; o[1024] = a4[2]; o[1536] = a4[3]; } }
                else if (col < MROWS) { const int s = col - MP, sb = s >> 4, si = s & 15; st_bf16x4((bf16*)(ws + WS_VATS) + ((size_t)(sb * 512 + row) * AKS + 512 + si), a4);
                    float* o = out + O_SAV + ((size_t)s * 512 + row); o[0] = a4[0]; o[512] = a4[1]; o[1024] = a4[2]; o[1536] = a4[3]; }
            } }
        } else if (u.gid == 2) {
            EPI_ROWS(256 * u.pm) EPI_COLS(256 * u.pn) st_bf16x4((bf16*)(ws + WS_MK) + (size_t)row * 512 + col, a4); *(f32x4*)(out + O_PMK + (size_t)row * 512 + col) = a4; } }
        } else {
            EPI_ROWS(256 * u.pm) EPI_COLS(256 * u.pn) const int b = col >> 8, mi = col & 255; st_bf16x4((bf16*)(ws + WS_MVT) + ((size_t)(b * 512 + row) * 256 + mi), a4);
                float* o = out + O_PMV + ((size_t)col * 512 + row); o[0] = a4[0]; o[512] = a4[1]; o[1024] = a4[2]; o[1536] = a4[3]; } }
        }
    }
};
__device__ __forceinline__ void row_stats(const float* st, int row, float& mu, float& rs) { const f32x2 s = *(const f32x2*)(st + 2 * (size_t)row); mu = s.x * (1.f / D); const float var = s.y * (1.f / D) - mu * mu; rs = __builtin_amdgcn_rsqf(var + LN_EPS); }

struct EpiP3 {
    static constexpr bool PERM = false, AFTER_DRAIN = false;
    const float* xp; const float* xs; float* V; bf16* AB; float* st;
    __device__ __forceinline__ void operator()(const f32x4 (&acc)[2][2][4][2], const pg8::Unit& u, int wr, int wc, int fr, int fq, int lane) const {
        EPI_ROWS(256 * u.pm) if (row < MROWS) { const float* x = row < MP ? xp + (size_t)row * D : xs + (size_t)(row - MP) * D; float s = 0.f, q = 0.f;
            EPI_COLS(256 * u.pn) const f32x4 v = *(const f32x4*)(x + col) * ALPHA + a4; *(f32x4*)(V + (size_t)row * D + col) = v; st_bf16x4(AB + (size_t)row * D + col, v);
                s += (v[0] + v[1]) + (v[2] + v[3]); q += (v[0] * v[0] + v[1] * v[1]) + (v[2] * v[2] + v[3] * v[3]); }
            s += xor16(s); s += xor32(s); q += xor16(q); q += xor32(q);
            if (fq == 0) { atomicAdd(st + 2 * (size_t)row, s); atomicAdd(st + 2 * (size_t)row + 1, q); } } }
    }
};
struct EpiP4a {
    static constexpr bool PERM = false, AFTER_DRAIN = false;
    const float* st; const float* cs; const float* bq; bf16* QM;
    __device__ __forceinline__ void operator()(const f32x4 (&acc)[2][2][4][2], const pg8::Unit& u, int wr, int wc, int fr, int fq, int lane) const {
        EPI_ROWS(256 * u.pm) if (row < MROWS) { float mu, rs; row_stats(st, row, mu, rs);
            EPI_COLS(256 * u.pn) const f32x4 c4 = *(const f32x4*)(cs + col), b4 = *(const f32x4*)(bq + col); st_bf16x4(QM + (size_t)row * 512 + col, ((a4 - c4 * mu) * rs + b4) * QMSCALE); } } }
    }
};
struct EpiRes {
    static constexpr bool PERM = false, AFTER_DRAIN = false;
    float* V; const float* st_old; const float* gam; const float* bet; bf16* AB; float* st_new;
    __device__ __forceinline__ void operator()(const f32x4 (&acc)[2][2][4][2], const pg8::Unit& u, int wr, int wc, int fr, int fq, int lane) const {
        EPI_ROWS(256 * u.pm) if (row < MROWS) { float mu, rs; row_stats(st_old, row, mu, rs); float s = 0.f, q = 0.f;
            EPI_COLS(256 * u.pn) const f32x4 vo = *(const f32x4*)(V + (size_t)row * D + col), g4 = *(const f32x4*)(gam + col), b4 = *(const f32x4*)(bet + col);
                const f32x4 v = ((vo - mu) * rs * g4 + b4) * ALPHA + a4; *(f32x4*)(V + (size_t)row * D + col) = v;
                if (AB) { st_bf16x4(AB + (size_t)row * D + col, v); s += (v[0] + v[1]) + (v[2] + v[3]); q += (v[0] * v[0] + v[1] * v[1]) + (v[2] * v[2] + v[3] * v[3]); } }
            if (AB) { s += xor16(s); s += xor32(s); q += xor16(q); q += xor32(q);
                if (fq == 0) { atomicAdd(st_new + 2 * (size_t)row, s); atomicAdd(st_new + 2 * (size_t)row + 1, q); } } } }
    }
};
struct EpiP5 {
    static constexpr bool PERM = false, AFTER_DRAIN = false;
    const float* st; const float* cs; const float* bu; const float* wconv; const float* bconv; const float* hist; bf16* H; float* out; LAS unsigned char* lds;
    __device__ __forceinline__ void operator()(const f32x4 (&acc)[2][2][4][2], const pg8::Unit& u, int wr, int wc, int fr, int fq, int lane) const {
        const bool smp = (u.pm == 65); const int R0 = smp ? MP : 254 * u.pm - 2;
        const int wcol = 256 * u.pn + 32 * wc + 4 * fq;
        const int hcol = 128 * u.pn + 32 * wc + 4 * fq;
        float mu[2][4], rs[2][4];
#pragma unroll
        for (int ai = 0; ai < 2; ++ai)
#pragma unroll
            for (int m = 0; m < 4; ++m) { int row = R0 + 128 * ai + 64 * wr + 16 * m + fr; row = row < 0 ? 0 : row; row_stats(st, row, mu[ai][m], rs[ai][m]); }
        LAS float* XG = (LAS float*)(lds + L_XG);
#pragma unroll
        for (int n = 0; n < 2; ++n) { const f32x4 cg = *(const f32x4*)(cs + wcol + 128 + 16 * n), bg = *(const f32x4*)(bu + wcol + 128 + 16 * n);
#pragma unroll
            for (int ai = 0; ai < 2; ++ai) { const f32x4 g3 = (acc[ai][1][3][n] - cg * mu[ai][3]) * rs[ai][3] + bg;
                if (fr >= 14) *(LAS f32x4*)(XG + ((ai * 2 + wr) * 2 + (fr - 14)) * 128 + 32 * wc + 16 * n + 4 * fq) = g3; } }
        asm volatile("s_waitcnt lgkmcnt(0)" ::: "memory"); __builtin_amdgcn_s_barrier(); asm volatile("" ::: "memory");
#pragma unroll
        for (int n = 0; n < 2; ++n) {
            const f32x4 cu = *(const f32x4*)(cs + wcol + 16 * n), b_u = *(const f32x4*)(bu + wcol + 16 * n), cg = *(const f32x4*)(cs + wcol + 128 + 16 * n), bg = *(const f32x4*)(bu + wcol + 128 + 16 * n);
            const int hc = hcol + 16 * n;
            const f32x4 w0 = *(const f32x4*)(wconv + hc), w1 = *(const f32x4*)(wconv + DFF + hc), w2 = *(const f32x4*)(wconv + 2 * DFF + hc), bc = *(const f32x4*)(bconv + hc);
#pragma unroll
            for (int ai = 0; ai < 2; ++ai) {
                f32x4 gprev = {0.f, 0.f, 0.f, 0.f};
#pragma unroll
                for (int m = 0; m < 4; ++m) {
                    const int loc = 128 * ai + 64 * wr + 16 * m + fr, row = R0 + loc;
                    const f32x4 g = (acc[ai][1][m][n] - cg * mu[ai][m]) * rs[ai][m] + bg;
                    const f32x4 uu = (acc[ai][0][m][n] - cu * mu[ai][m]) * rs[ai][m] + b_u;
                    f32x4 pv = gprev;
                    if (smp) { const int sb = 8 * ai + 4 * wr + m; pv = (f32x4){0.f, 0.f, 0.f, 0.f};
                        if (fr >= 14 && sb < 8) pv = *(const f32x4*)(hist + ((size_t)(sb * 2 + (fr - 14)) * DFF + hc)); }
                    else if (m == 0) { const int pg = ai * 2 + wr - 1;
                        pv = (f32x4){0.f, 0.f, 0.f, 0.f}; if (fr >= 14 && pg >= 0) pv = *(LAS f32x4*)(XG + (pg * 2 + (fr - 14)) * 128 + 32 * wc + 16 * n + 4 * fq); }
                    f32x4 g1, g2;
#pragma unroll
                    for (int j = 0; j < 4; ++j) { const float a1 = ror1(g[j]), p1 = ror1(pv[j]), a2 = ror2(g[j]), p2 = ror2(pv[j]); g1[j] = fr >= 1 ? a1 : p1; g2[j] = fr >= 2 ? a2 : p2; }
                    if (!smp) { const int t = row & 4095; if (t == 0) { g1 = (f32x4){0.f, 0.f, 0.f, 0.f}; g2 = g1; } else if (t == 1) g2 = (f32x4){0.f, 0.f, 0.f, 0.f}; }
                    const f32x4 gc = bc + w0 * g2 + w1 * g1 + w2 * g;
                    f32x4 h; h[0] = uu[0] * gelu_tanh(gc[0]); h[1] = uu[1] * gelu_tanh(gc[1]); h[2] = uu[2] * gelu_tanh(gc[2]); h[3] = uu[3] * gelu_tanh(gc[3]);
                    const bool valid = smp ? (row < MROWS) : (loc >= 2 && row < MP);
                    if (valid) { st_bf16x4(H + (size_t)row * DFF + hc, h);
                        if (!smp) { const int t = row & 4095; if (t >= 4094) *(f32x4*)(out + O_PFC + ((size_t)((row >> 12) * 2 + (t - 4094)) * DFF + hc)) = g; }
                        else { const int s = row - MP, si = s & 15; if (si >= 14) *(f32x4*)(out + O_SFC + ((size_t)((s >> 4) * 2 + (si - 14)) * DFF + hc)) = g; } }
                    gprev = g;
                }
            }
        }
    }
};
template <int NQT>
__device__ __forceinline__ void band_unit(const bf16* Qp, const bf16* Kp, const bf16* VTp, int pv, int nkeys, int key0pos, int qpos0, bf16* Op, const LAS float* ab, int lane) {
    asm volatile("" : "+v"(lane));
    const int c16 = lane & 15, g = lane >> 4;
    bf16x8 qf[NQT][2];
#pragma unroll
    for (int nt = 0; nt < NQT; ++nt)
#pragma unroll
        for (int ks = 0; ks < 2; ++ks) qf[nt][ks] = *(const bf16x8*)(Qp + (size_t)(16 * nt + c16) * 1024 + 32 * ks + 8 * g);
    f32x4 O[4][NQT]; f32x4 negm[NQT]; float lsum[NQT];
#pragma unroll
    for (int nt = 0; nt < NQT; ++nt) { negm[nt] = (f32x4){0.f, 0.f, 0.f, 0.f}; lsum[nt] = 0.f;
#pragma unroll
        for (int mt = 0; mt < 4; ++mt) O[mt][nt] = (f32x4){0.f, 0.f, 0.f, 0.f}; }
    const int nblk = (nkeys + 31) >> 5;
    for (int kb = 0; kb < nblk; ++kb) {
        const bf16* kr = Kp + (size_t)(32 * kb + c16) * 512 + 8 * g;
        bf16x8 ka[2][2];
#pragma unroll
        for (int tl = 0; tl < 2; ++tl)
#pragma unroll
            for (int ks = 0; ks < 2; ++ks) ka[tl][ks] = *(const bf16x8*)(kr + (size_t)tl * 16 * 512 + 32 * ks);
        const bf16* vr = VTp + (size_t)c16 * pv + 32 * kb + 4 * g;
        s16x4 vlo[4], vhi[4];
#pragma unroll
        for (int mt = 0; mt < 4; ++mt) { vlo[mt] = *(const s16x4*)(vr + (size_t)16 * mt * pv); vhi[mt] = *(const s16x4*)(vr + (size_t)16 * mt * pv + 16); }
        f32x4 S[2][NQT];
#pragma unroll
        for (int tl = 0; tl < 2; ++tl)
#pragma unroll
            for (int nt = 0; nt < NQT; ++nt) { S[tl][nt] = MFMA16(ka[tl][0], qf[nt][0], negm[nt]); S[tl][nt] = MFMA16(ka[tl][1], qf[nt][1], S[tl][nt]); }
        const int kp0 = key0pos + 32 * kb;
        if (kp0 + 31 + 64 > qpos0) {
#pragma unroll
            for (int tl = 0; tl < 2; ++tl)
#pragma unroll
                for (int nt = 0; nt < NQT; ++nt)
#pragma unroll
                    for (int r = 0; r < 4; ++r) { int i = (qpos0 + 16 * nt + c16) - (kp0 + 16 * tl + 4 * g + r) + 64; i = i > 191 ? 191 : i; i = i < 0 ? 0 : i; S[tl][nt][r] += ab[i]; }
        }
        if (32 * kb + 32 > nkeys) {
#pragma unroll
            for (int tl = 0; tl < 2; ++tl)
#pragma unroll
                for (int nt = 0; nt < NQT; ++nt)
#pragma unroll
                    for (int r = 0; r < 4; ++r) if (32 * kb + 16 * tl + 4 * g + r >= nkeys) S[tl][nt][r] = -INFINITY;
        }
        const bool first = (kb == 0);
#pragma unroll
        for (int nt = 0; nt < NQT; ++nt) {
            float bm = fmaxf(fmaxf(fmaxf(S[0][nt][0], S[0][nt][1]), fmaxf(S[0][nt][2], S[0][nt][3])), fmaxf(fmaxf(S[1][nt][0], S[1][nt][1]), fmaxf(S[1][nt][2], S[1][nt][3])));
            bm = fmaxf(bm, xor16(bm)); bm = fmaxf(bm, xor32(bm));
            if (first || __any(bm > 8.f)) {
                const float dl = first ? bm : fmaxf(bm, 0.f);
                negm[nt] = negm[nt] - dl; S[0][nt] = S[0][nt] - dl; S[1][nt] = S[1][nt] - dl;
                if (!first) { const float f = __builtin_amdgcn_exp2f(-dl); lsum[nt] *= f;
#pragma unroll
                    for (int mt = 0; mt < 4; ++mt) O[mt][nt] = O[mt][nt] * f; }
            }
#pragma unroll
            for (int tl = 0; tl < 2; ++tl)
#pragma unroll
                for (int r = 0; r < 4; ++r) S[tl][nt][r] = __builtin_amdgcn_exp2f(S[tl][nt][r]);
            lsum[nt] += ((S[0][nt][0] + S[0][nt][1]) + (S[0][nt][2] + S[0][nt][3])) + ((S[1][nt][0] + S[1][nt][1]) + (S[1][nt][2] + S[1][nt][3]));
        }
        bf16x8 pB[NQT];
#pragma unroll
        for (int nt = 0; nt < NQT; ++nt) pB[nt] = pack8(S[0][nt], S[1][nt]);
#pragma unroll
        for (int mt = 0; mt < 4; ++mt) { const bf16x8 va = (bf16x8){vlo[mt][0], vlo[mt][1], vlo[mt][2], vlo[mt][3], vhi[mt][0], vhi[mt][1], vhi[mt][2], vhi[mt][3]};
#pragma unroll
            for (int nt = 0; nt < NQT; ++nt) O[mt][nt] = MFMA16(va, pB[nt], O[mt][nt]); }
    }
#pragma unroll
    for (int nt = 0; nt < NQT; ++nt) { float l = lsum[nt]; l += xor16(l); l += xor32(l); const float inv = 1.0f / l;
#pragma unroll
        for (int mt = 0; mt < 4; ++mt) st_bf16x4(Op + (size_t)(16 * nt + c16) * 1024 + 16 * mt + 4 * g, O[mt][nt] * inv); }
}

__device__ __forceinline__ unsigned lut_bucket(const LAS unsigned char* lut, int rel) { rel = rel < -64 ? -64 : rel; rel = rel > 191 ? 191 : rel; return lut[rel + 64]; }
__device__ __forceinline__ void dsa_unit(LAS unsigned char* lds, bf16* Q2, const bf16* QI, const float* WI, int rowq0, int L, int qpos0, const bf16* KIp, const bf16* KBp, const bf16* VBp, int wave, int lane) {
    asm volatile("" : "+v"(lane));
    int c16 = lane & 15, g = lane >> 4;
    const LAS unsigned char* lut = lds + L_LUT; const LAS float* t5 = (const LAS float*)(lds + L_T5);
#ifndef DSA_NO_A
    {
        const f32x4 w0 = *(const f32x4*)(WI + (size_t)(rowq0 + c16) * 8), w1 = *(const f32x4*)(WI + (size_t)(rowq0 + c16) * 8 + 4);
        const float wi[8] = {w0[0], w0[1], w0[2], w0[3], w1[0], w1[1], w1[2], w1[3]};
        bf16x8 bq[8][2]; float lo[8], hi[8];
#pragma unroll
        for (int h = 0; h < 8; ++h) { lo[h] = wi[h] >= 0.f ? 0.f : -INFINITY; hi[h] = wi[h] >= 0.f ? INFINITY : 0.f;
#pragma unroll
            for (int ks = 0; ks < 2; ++ks) { const bf16x8 raw = *(const bf16x8*)(QI + (size_t)(rowq0 + c16) * 512 + h * 64 + 32 * ks + 8 * g); u32x4 w;
                w.x = cvtpk(bf2f(raw[0]) * wi[h], bf2f(raw[1]) * wi[h]); w.y = cvtpk(bf2f(raw[2]) * wi[h], bf2f(raw[3]) * wi[h]);
                w.z = cvtpk(bf2f(raw[4]) * wi[h], bf2f(raw[5]) * wi[h]); w.w = cvtpk(bf2f(raw[6]) * wi[h], bf2f(raw[7]) * wi[h]); bq[h][ks] = __builtin_bit_cast(bf16x8, w); } }
        const int ntile = L >> 4;
        for (int t = wave; t < ntile; t += 8) {
            const bf16* kp = KIp + (size_t)(16 * t + c16) * 64 + 8 * g;
            const bf16x8 a0 = *(const bf16x8*)kp, a1 = *(const bf16x8*)(kp + 32);
            f32x4 sc = {0.f, 0.f, 0.f, 0.f};
#pragma unroll
            for (int h = 0; h < 8; ++h) { f32x4 y = MFMA16(a0, bq[h][0], ((f32x4){0.f, 0.f, 0.f, 0.f})); y = MFMA16(a1, bq[h][1], y);
#pragma unroll
                for (int r = 0; r < 4; ++r) sc[r] += __builtin_amdgcn_fmed3f(y[r], lo[h], hi[h]); }
            typedef _Float16 h4 __attribute__((ext_vector_type(4)));
            h4 hv; hv[0] = (_Float16)sc[0]; hv[1] = (_Float16)sc[1]; hv[2] = (_Float16)sc[2]; hv[3] = (_Float16)sc[3];
            *(LAS h4*)(lds + c16 * SC_STRIDE + (16 * t + 4 * g) * 2) = hv;
        }
    }
#endif
    __syncthreads();
    asm volatile("" : "+v"(lane)); c16 = lane & 15; g = lane >> 4;
    const int cnt = L < 256 ? L : 256;
#ifndef DSA_NO_B
#pragma unroll 1
    for (int qq = 0; qq < 2; ++qq) {
        const int q = 2 * wave + qq, qpos = qpos0 + q;
        LAS unsigned* sel = (LAS unsigned*)(lds + L_SEL) + q * 256;
        if (L <= 256) {
            for (int j = lane; j < 256; j += 64) { const int idx = j < L ? j : 0; sel[j] = (unsigned)idx | (lut_bucket(lut, qpos - idx) << 16); }
        } else {
            const LAS unsigned short* srow = (const LAS unsigned short*)(lds + q * SC_STRIDE);
            const int nreg = (L + 63) >> 6;
            unsigned u[64];
#pragma unroll
            for (int i = 0; i < 64; ++i) { const int key = i * 64 + lane; unsigned v = 0u;
                if (i < nreg && key < L) { const unsigned b = srow[key]; v = (b & 0x8000u) ? (~b & 0xffffu) : (b | 0x8000u); }
                u[i] = v; }
            unsigned T = 0u;
#pragma unroll 1
            for (int bit = 15; bit >= 0; --bit) { const unsigned cand = T | (1u << bit); int c = 0;
#pragma unroll
                for (int ch = 0; ch < 8; ++ch) if (8 * ch < nreg) {
#pragma unroll
                    for (int i = 0; i < 8; ++i) c += __builtin_popcountll(__ballot(u[8 * ch + i] >= cand)); }
                if (c >= 256) T = cand; }
            int cgt = 0;
#pragma unroll
            for (int ch = 0; ch < 8; ++ch) if (8 * ch < nreg) {
#pragma unroll
                for (int i = 0; i < 8; ++i) cgt += __builtin_popcountll(__ballot(u[8 * ch + i] > T)); }
            const int need = 256 - cgt; int base = 0, eqs = 0;
#pragma unroll
            for (int ch = 0; ch < 8; ++ch) if (8 * ch < nreg) {
#pragma unroll
                for (int i = 0; i < 8; ++i) { const unsigned v = u[8 * ch + i]; const bool eq = (v == T);
                    const unsigned long long meq = __ballot(eq);
                    const int erank = eqs + (int)__builtin_amdgcn_mbcnt_hi((unsigned)(meq >> 32), __builtin_amdgcn_mbcnt_lo((unsigned)meq, 0u));
                    const bool take = (v > T) || (eq && erank < need);
                    const unsigned long long mt = __ballot(take);
                    const int pos = base + (int)__builtin_amdgcn_mbcnt_hi((unsigned)(mt >> 32), __builtin_amdgcn_mbcnt_lo((unsigned)mt, 0u));
                    if (take) { const int idx = (8 * ch + i) * 64 + lane; sel[pos] = (unsigned)idx | (lut_bucket(lut, qpos - idx) << 16); }
                    base += __builtin_popcountll(mt); eqs += __builtin_popcountll(meq); } }
        }
    }
#endif
#ifndef DSA_NO_C
    asm volatile("" : "+v"(lane)); c16 = lane & 15; g = lane >> 4;
    LAS unsigned char* vbuf = lds + (2 * wave) * SC_STRIDE;
#pragma unroll 1
    for (int qq = 0; qq < 2; ++qq) {
        const int q = 2 * wave + qq, row = rowq0 + q;
        const LAS unsigned* sel = (const LAS unsigned*)(lds + L_SEL) + q * 256;
        const int head = c16;
        bf16x8 qf[4];
#pragma unroll
        for (int ks = 0; ks < 4; ++ks) { qf[ks] = (bf16x8){0, 0, 0, 0, 0, 0, 0, 0};
            if (head < 8 && (head >> 2) == (ks >> 1)) qf[ks] = *(const bf16x8*)(Q2 + (size_t)row * 1024 + 512 + head * 64 + 32 * (ks & 1) + 8 * g); }
        f32x4 S[16];
#pragma unroll
        for (int kt = 0; kt < 16; ++kt) { const unsigned e = sel[kt * 16 + c16]; const bf16* kp = KBp + (size_t)(e & 0xffffu) * 128 + 8 * g;
            f32x4 s = {0.f, 0.f, 0.f, 0.f};
#pragma unroll
            for (int ks = 0; ks < 4; ++ks) s = MFMA16(*(const bf16x8*)(kp + 32 * ks), qf[ks], s);
            S[kt] = s; if ((kt & 3) == 3) __builtin_amdgcn_sched_barrier(0); }
        float mx = -INFINITY;
#pragma unroll
        for (int kt = 0; kt < 16; ++kt)
#pragma unroll
            for (int r = 0; r < 4; ++r) { const int j = kt * 16 + 4 * g + r; const unsigned e = sel[j]; float s = S[kt][r] + t5[(e >> 16) * 8 + (head & 7)]; s = j < cnt ? s : -INFINITY; S[kt][r] = s; mx = fmaxf(mx, s); }
        mx = fmaxf(mx, xor16(mx)); mx = fmaxf(mx, xor32(mx));
        float l = 0.f;
#pragma unroll
        for (int kt = 0; kt < 16; ++kt)
#pragma unroll
            for (int r = 0; r < 4; ++r) { const float p = __builtin_amdgcn_exp2f(S[kt][r] - mx); S[kt][r] = p; l += p; }
        l += xor16(l); l += xor32(l);
        f32x4 O[8];
#pragma unroll
        for (int mt = 0; mt < 8; ++mt) O[mt] = (f32x4){0.f, 0.f, 0.f, 0.f};
#pragma unroll
        for (int t = 0; t < 8; ++t) {
#pragma unroll
            for (int i = 0; i < 8; ++i) { const int kk = 4 * i + g; const unsigned e = sel[32 * t + kk];
                const u32x4 v = *(const u32x4*)(VBp + (size_t)(e & 0xffffu) * 128 + c16 * 8);
                *(LAS u32x4*)(vbuf + kk * 288 + c16 * 16) = v; }
            const bf16x8 pB = pack8(S[2 * t], S[2 * t + 1]);
            const LAS unsigned char* vb = vbuf + (4 * g + (c16 >> 2)) * 288 + (c16 & 3) * 8;
#pragma unroll
            for (int mt = 0; mt < 8; ++mt) { const s16x4 lo4 = tr_read(vb + mt * 32), hi4 = tr_read(vb + 16 * 288 + mt * 32);
                const bf16x8 va = (bf16x8){lo4[0], lo4[1], lo4[2], lo4[3], hi4[0], hi4[1], hi4[2], hi4[3]};
                O[mt] = MFMA16(va, pB, O[mt]); }
            __builtin_amdgcn_sched_barrier(0);
        }
        const float inv = 1.0f / l;
#pragma unroll
        for (int mt = 0; mt < 8; ++mt) if (head < 8 && (mt >> 2) == (head >> 2)) st_bf16x4(Q2 + (size_t)row * 1024 + 512 + head * 64 + 16 * (mt & 3) + 4 * g, O[mt] * inv);
    }
#endif
    __syncthreads();
}

__device__ __forceinline__ void p2_attention(Frame& F) {
    unsigned char* ws = F.ws; const int tid = F.tid, lane = F.lane, wave = F.wave;
    { LAS float* t5 = (LAS float*)(F.lds + L_T5); LAS unsigned char* lut = F.lds + L_LUT; LAS float* ab = (LAS float*)(F.lds + L_ABIAS);
      if (tid < 256) { t5[tid] = F.in[I_T5][tid] * LOG2E;
          const int rel = tid - 64, n = rel < 0 ? -rel : rel; int bk;
          if (n < 8) bk = n; else { int v = 8 + (int)(2.0f * __log2f((float)n * 0.125f) + 1e-4f); bk = v > 15 ? 15 : v; }
          lut[tid] = (unsigned char)((rel < 0 ? 16 : 0) + bk); }
      for (int i = tid; i < 8 * 192; i += NWAVES * 64) { const int h = i / 192, j = i % 192; const int jj = j > 128 ? 128 : j;
          ab[i] = (F.in[I_AREL][jj * 8 + h] - F.in[I_AREL][128 * 8 + h]) * LOG2E; }
      __syncthreads(); }
    bf16* Q2 = (bf16*)(ws + WS_Q2);
    for (int slot = F.vcu; slot < 256; slot += F.G) {
        const int b = slot >> 6, c = slot & 63;
#ifndef NO_BAND4
        { const int kc0 = c > 8 ? c - 8 : 0, h = wave;
          band_unit<4>(Q2 + (size_t)(b * 4096 + 64 * c) * 1024 + h * 64, (const bf16*)(ws + WS_KA) + (size_t)(b * 4096 + 64 * kc0) * 512 + h * 64,
                       (const bf16*)(ws + WS_VAT) + (size_t)(b * 512 + h * 64) * 4096 + 64 * kc0, 4096, 64 * (c - kc0 + 1), 64 * kc0, 64 * c,
                       Q2 + (size_t)(b * 4096 + 64 * c) * 1024 + h * 64, (const LAS float*)(F.lds + L_ABIAS) + h * 192, lane); }
#endif
#ifndef NO_DSA
        { const int p = c >> 1, s2 = c & 1;
#pragma unroll 1
          for (int k = 0; k < 4; ++k) { const int cc = (k < 2) ? p : 63 - p, ss = 2 * s2 + (k & 1);
              dsa_unit(F.lds, Q2, (const bf16*)(ws + WS_QI), (const float*)(ws + WS_WI), b * 4096 + 64 * cc + 16 * ss, 64 * (cc + 1), 64 * cc + 16 * ss,
                       (const bf16*)(ws + WS_KI) + (size_t)b * 4096 * 64, (const bf16*)(ws + WS_KB) + (size_t)b * 4096 * 128, (const bf16*)(ws + WS_VB) + (size_t)b * 4096 * 128, wave, lane); } }
#endif
#ifndef NO_SAMPLE
        if (slot < 8) { const int sb = slot;
            dsa_unit(F.lds, Q2, (const bf16*)(ws + WS_QI), (const float*)(ws + WS_WI), MP + 16 * sb, BKS, PAST,
                     (const bf16*)(ws + WS_KIS) + (size_t)sb * BKS * 64, (const bf16*)(ws + WS_KBS) + (size_t)sb * BKS * 128, (const bf16*)(ws + WS_VBS) + (size_t)sb * BKS * 128, wave, lane); }
        else if (slot < 16) { const int sb = slot - 8, h = wave;
            band_unit<1>(Q2 + (size_t)(MP + 16 * sb) * 1024 + h * 64, (const bf16*)(ws + WS_KAS) + (size_t)sb * AKS * 512 + h * 64,
                         (const bf16*)(ws + WS_VATS) + (size_t)(sb * 512 + h * 64) * AKS, AKS, AKS, 0, 512,
                         Q2 + (size_t)(MP + 16 * sb) * 1024 + h * 64, (const LAS float*)(F.lds + L_ABIAS) + h * 192, lane); }
#endif
    }
}

__device__ __forceinline__ void mem_unit(bf16* QM, int row0, int h, const bf16* Kp, const bf16* VTp, int lane) {
    asm volatile("" : "+v"(lane));
    const int c16 = lane & 15, g = lane >> 4;
    bf16x8 qf[4];
#pragma unroll
    for (int ks = 0; ks < 4; ++ks) qf[ks] = *(const bf16x8*)(QM + (size_t)(row0 + c16) * 512 + h * 128 + 32 * ks + 8 * g);
    f32x4 S[16]; float mx = -INFINITY;
#pragma unroll
    for (int kt = 0; kt < 16; ++kt) { const bf16* kp = Kp + (size_t)(16 * kt + c16) * 512 + 8 * g; f32x4 s = {0.f, 0.f, 0.f, 0.f};
#pragma unroll
        for (int ks = 0; ks < 4; ++ks) s = MFMA16(*(const bf16x8*)(kp + 32 * ks), qf[ks], s);
        S[kt] = s; mx = fmaxf(mx, fmaxf(fmaxf(s[0], s[1]), fmaxf(s[2], s[3]))); if ((kt & 3) == 3) __builtin_amdgcn_sched_barrier(0); }
    mx = fmaxf(mx, xor16(mx)); mx = fmaxf(mx, xor32(mx));
    float l = 0.f;
#pragma unroll
    for (int kt = 0; kt < 16; ++kt)
#pragma unroll
        for (int r = 0; r < 4; ++r) { const float p = __builtin_amdgcn_exp2f(S[kt][r] - mx); S[kt][r] = p; l += p; }
    l += xor16(l); l += xor32(l);
    f32x4 O[8];
#pragma unroll
    for (int mt = 0; mt < 8; ++mt) O[mt] = (f32x4){0.f, 0.f, 0.f, 0.f};
#pragma unroll
    for (int t = 0; t < 8; ++t) { const bf16x8 pB = pack8(S[2 * t], S[2 * t + 1]);
#pragma unroll
        for (int mt = 0; mt < 8; ++mt) { const bf16* vr = VTp + (size_t)(16 * mt + c16) * 256 + 32 * t + 4 * g; const s16x4 lo4 = *(const s16x4*)vr, hi4 = *(const s16x4*)(vr + 16);
            const bf16x8 va = (bf16x8){lo4[0], lo4[1], lo4[2], lo4[3], hi4[0], hi4[1], hi4[2], hi4[3]};
            O[mt] = MFMA16(va, pB, O[mt]); }
        if (t & 1) __builtin_amdgcn_sched_barrier(0); }
    const float inv = 1.0f / l;
#pragma unroll
    for (int mt = 0; mt < 8; ++mt) st_bf16x4(QM + (size_t)(row0 + c16) * 512 + h * 128 + 16 * mt + 4 * g, O[mt] * inv);
}
__device__ __forceinline__ void p4b_memattn(Frame& F) {
    unsigned char* ws = F.ws; const int gw = F.vcu * NWAVES + F.wave, NGW = F.G * NWAVES;
    for (int uid = gw; uid < (MROWS / 16) * 4; uid += NGW) { const int rg = uid >> 2, h = uid & 3, row0 = 16 * rg;
        const bf16* Kp; const bf16* VTp;
        if (row0 < MP) { const int b = row0 >> 12; Kp = (const bf16*)(ws + WS_MK) + (size_t)b * 256 * 512 + h * 128; VTp = (const bf16*)(ws + WS_MVT) + (size_t)(b * 512 + h * 128) * 256; }
        else { const int sb = (row0 - MP) >> 4; Kp = (const bf16*)(ws + WS_MKS) + (size_t)sb * 256 * 512 + h * 128; VTp = (const bf16*)(ws + WS_MVTS) + (size_t)(sb * 512 + h * 128) * 256; }
        mem_unit((bf16*)(ws + WS_QM), row0, h, Kp, VTp, F.lane); }
}
__device__ __forceinline__ void p7_ln3(Frame& F) {
    const int gw = F.vcu * NWAVES + F.wave, NGW = F.G * NWAVES; const float* g3 = F.in[I_G3]; const float* b3 = F.in[I_B3];
    for (int row = gw; row < MROWS; row += NGW) { f32x4* xr = (f32x4*)(F.out + (size_t)row * D) + F.lane; f32x4 v[4]; float s = 0.f;
#pragma unroll
        for (int j = 0; j < 4; ++j) { v[j] = xr[64 * j]; s += (v[j][0] + v[j][1]) + (v[j][2] + v[j][3]); }
#pragma unroll
        for (int o = 1; o < 64; o <<= 1) s += __shfl_xor(s, o);
        const float mean = s * (1.f / D); float s2 = 0.f;
#pragma unroll
        for (int j = 0; j < 4; ++j) { v[j] = v[j] - mean; s2 += (v[j][0] * v[j][0] + v[j][1] * v[j][1]) + (v[j][2] * v[j][2] + v[j][3] * v[j][3]); }
#pragma unroll
        for (int o = 1; o < 64; o <<= 1) s2 += __shfl_xor(s2, o);
        const float rstd = 1.f / sqrtf(s2 * (1.f / D) + LN_EPS);
#pragma unroll
        for (int j = 0; j < 4; ++j) { const f32x4 gg = *((const f32x4*)g3 + F.lane + 64 * j), bb = *((const f32x4*)b3 + F.lane + 64 * j); xr[64 * j] = v[j] * rstd * gg + bb; } }
}
struct Args { const float* in[N_IN]; float* out; unsigned char* ws; int ph_lo, ph_hi, li, pad; };
static_assert(sizeof(Args) == N_IN * 8 + 16 + 16, "Args has no padding");

__global__ void __launch_bounds__(NWAVES * 64, 2) fwd_megakernel(Args args) {
    extern __shared__ __attribute__((aligned(16))) unsigned char lds[];
    Frame F;
    F.lds = (LAS unsigned char*)lds;
    F.MISC = (volatile LAS unsigned*)(F.lds + L_MISC);
    F.tid = threadIdx.x; F.lane = F.tid & 63; F.wave = __builtin_amdgcn_readfirstlane(F.tid >> 6);
    F.G = gridDim.x; { const int bx = blockIdx.x; F.vcu = (F.G % 8 == 0) ? (bx % 8) * (F.G / 8) + bx / 8 : bx; }
    F.ws = args.ws; F.ctl = (gu32*)(args.ws + WS_CTL); F.in = args.in; F.out = args.out;
    unsigned char* ws = args.ws;
    for (int u = F.tid; u < 128; u += NWAVES * 64) ((LAS unsigned*)(F.lds + L_MISC))[u] = 0u;
    __syncthreads();
    const bool one_launch = (args.ph_hi - args.ph_lo) > 1;
    XcdBarrier bar; bar.bar = (unsigned*)(F.ctl + CW_BAR); bar.x = 0; bar.st = nullptr;
    if (one_launch) bar = xcd_barrier_post((unsigned*)(F.ctl + CW_BAR), F.MISC + 8);
    const int lo = args.ph_lo, hi = args.ph_hi;
#ifndef PH_MASK
#define PH_MASK 0x3ff
#endif
#define IN(k) (((PH_MASK >> (k)) & 1) && lo <= (k) && (k) < hi)
#define SEAM(k) do { if (IN(k) && IN((k) + 1)) xcd_barrier(bar); } while (0)
    const int bx = (int)blockIdx.x;

    if (IN(0)) { p0_prologue(F); SEAM(0); }

    if (IN(1)) {
        SchedP1 S{F.G, bx, (const char*)(ws + WS_AB), (const char*)(ws + WS_WIN), (const char*)(ws + WS_WVA), (const char*)(ws + WS_MEMB), (const char*)(ws + WS_WMK), (const char*)(ws + WS_WMV)};
        EpiP1 E{ws, F.out};
        pg8::gemm_phase<EpiP1, SchedP1, true, true>(F.lds, 1024, S, E);
        SEAM(1);
    }
    if (IN(2)) { p2_attention(F); SEAM(2); }

    if (IN(3)) {
        SchedPlain S{65, 4, F.G, bx, (const char*)(ws + WS_Q2), (const char*)(ws + WS_WO), 2048};
        EpiP3 E{F.in[I_XP], F.in[I_XS], F.out, (bf16*)(ws + WS_AB), (float*)(ws + CT_ST1)};
        pg8::gemm_phase<EpiP3, SchedPlain, true, true>(F.lds, 1024, S, E);
        SEAM(3);
    }
    if (IN(4)) {
        SchedPlain S{65, 2, F.G, bx, (const char*)(ws + WS_AB), (const char*)(ws + WS_WMQ), 2048};
        EpiP4a E{(const float*)(ws + CT_ST1), (const float*)(ws + CT_CSQ), (const float*)(ws + CT_BQ), (bf16*)(ws + WS_QM)};
        pg8::gemm_phase<EpiP4a, SchedPlain, true, true>(F.lds, 1024, S, E);
        SEAM(4);
    }
    if (IN(5)) { p4b_memattn(F); SEAM(5); }

    if (IN(6)) {
        SchedPlain S{65, 4, F.G, bx, (const char*)(ws + WS_QM), (const char*)(ws + WS_WMO), 1024};
        EpiRes E{F.out, (const float*)(ws + CT_ST1), F.in[I_G1], F.in[I_B1], (bf16*)(ws + WS_AB), (float*)(ws + CT_ST2)};
        pg8::gemm_phase<EpiRes, SchedPlain, true, true>(F.lds, 512, S, E);
        SEAM(6);
    }
    if (IN(7)) {
        SchedP5 S{F.G, bx, (const char*)(ws + WS_AB), (const char*)(ws + WS_WUP)};
        EpiP5 E{(const float*)(ws + CT_ST2), (const float*)(ws + CT_CSU), (const float*)(ws + CT_BU), F.in[I_WCONV], F.in[I_BCONV], F.in[I_FFN], (bf16*)(ws + WS_HMID), F.out, F.lds};
        pg8::gemm_phase<EpiP5, SchedP5, true, true>(F.lds, 1024, S, E);
        SEAM(7);
    }
    if (IN(8)) {
        SchedPlain S{65, 4, F.G, bx, (const char*)(ws + WS_HMID), (const char*)(ws + WS_WDN), (size_t)DFF * 2};
        EpiRes E{F.out, (const float*)(ws + CT_ST2), F.in[I_G2], F.in[I_B2], nullptr, nullptr};
        pg8::gemm_phase<EpiRes, SchedPlain, true, true>(F.lds, DFF, S, E);
        SEAM(8);
    }
    if (IN(9)) { p7_ln3(F); }
#undef IN
#undef SEAM
}

extern "C" void kernel_launch(void* const* d_in, const int* in_sizes, int n_in, void* d_out, int out_size, void* d_ws, size_t ws_size, hipStream_t stream) {
    static int grid = 0;
    if (grid == 0) {
        if (n_in != N_IN || out_size != (int)O_END || ws_size < WS_END) { fprintf(stderr, "kernel_launch: unexpected problem: n_in %d out %d ws %zu\n", n_in, out_size, ws_size); grid = -1; return; }
        int dev = 0, cus = 0, per_cu = 0;
        if (hipGetDevice(&dev) != hipSuccess || hipDeviceGetAttribute(&cus, hipDeviceAttributeMultiprocessorCount, dev) != hipSuccess) { grid = -1; return; }
        if (hipFuncSetAttribute((const void*)fwd_megakernel, hipFuncAttributeMaxDynamicSharedMemorySize, LDS_BYTES) != hipSuccess) { fprintf(stderr, "kernel_launch: hipFuncSetAttribute failed\n"); grid = -1; return; }
        if (hipOccupancyMaxActiveBlocksPerMultiprocessor(&per_cu, (const void*)fwd_megakernel, NWAVES * 64, LDS_BYTES) != hipSuccess || per_cu < 1)
            fprintf(stderr, "kernel_launch: note: occupancy query reports %d workgroups per CU\n", per_cu);
        (void)hipGetLastError();
        grid = cus;
    }
    if (grid < 0) return;
    if (hipMemsetAsync((char*)d_ws + WS_CTL, 0, CTL_ZERO_BYTES, stream) != hipSuccess) { fprintf(stderr, "kernel_launch: memset failed\n"); return; }
    Args a{};
    for (int i = 0; i < N_IN; ++i) a.in[i] = (const float*)d_in[i];
    a.out = (float*)d_out; a.ws = (unsigned char*)d_ws;
#if MK_N_LAUNCHES == 1
    a.ph_lo = 0; a.ph_hi = N_PHASES; a.li = 0;
    hipLaunchKernelGGL(fwd_megakernel, dim3(grid), dim3(NWAVES * 64), LDS_BYTES, stream, a);
#else
    for (int li = 0; li < N_PHASES; ++li) { a.ph_lo = li; a.ph_hi = li + 1; a.li = li;
        hipLaunchKernelGGL(fwd_megakernel, dim3(grid), dim3(NWAVES * 64), LDS_BYTES, stream, a); }
#endif
    const hipError_t le = hipPeekAtLastError();
    if (le != hipSuccess) fprintf(stderr, "kernel_launch: launch failed: %s\n", hipGetErrorName(le));
}
```

```cpp
#include <hip/hip_runtime.h>
#include <cstdio>
#include <cstdint>

#define GAS __attribute__((address_space(1)))
#define LAS __attribute__((address_space(3)))
typedef unsigned short bf16;
typedef short bf16x8 __attribute__((ext_vector_type(8)));
typedef short s16x4 __attribute__((ext_vector_type(4)));
typedef float f32x4 __attribute__((ext_vector_type(4)));
typedef float f32x2 __attribute__((ext_vector_type(2)));
typedef unsigned u32x4 __attribute__((ext_vector_type(4)));
typedef unsigned u32x2 __attribute__((ext_vector_type(2)));
typedef GAS unsigned gu32;

constexpr int D = 1024, NBATCH = 4, SEQ = 4096, MP = NBATCH * SEQ;
constexpr int DB = 8, DS = 16, MS = DB * DS, PAST = 2048;
constexpr int MROWS = MP + MS;
constexpr int MT = MP + 256;
constexpr int DFF = 2816, NUP = 2 * DFF;
constexpr int AKS = 528;
constexpr int BKS = PAST + DS;
constexpr int NMAIN = 2560;
constexpr float ALPHA = 1.189207115002721f;
constexpr float LN_EPS = 1e-5f;
constexpr float LOG2E = 1.4426950408889634f;
constexpr float QSCALE = 0.125f * LOG2E;
constexpr float QMSCALE = 0.08838834764831845f * LOG2E;
constexpr float WISCALE = 0.35355339059327373f * 0.125f;

enum { I_XP = 0, I_XS, I_CAK, I_CAV, I_CBK, I_CBV, I_CBI, I_CMK, I_CMV, I_FFN, I_MEM, I_WIN, I_AREL, I_T5, I_WO, I_G1, I_B1, I_WMQ, I_WMK, I_WMV, I_WMO, I_G2, I_B2,
       I_WUP, I_WCONV, I_BCONV, I_WDN, I_G3, I_B3, N_IN };

constexpr size_t O_YP = 0;
constexpr size_t O_YS = O_YP + (size_t)MP * D;
constexpr size_t O_PAK = O_YS + (size_t)MS * D;
constexpr size_t O_PAV = O_PAK + (size_t)NBATCH * 512 * 512;
constexpr size_t O_PBK = O_PAV + (size_t)NBATCH * 512 * 512;
constexpr size_t O_PBV = O_PBK + (size_t)MP * 128;
constexpr size_t O_PBI = O_PBV + (size_t)MP * 128;
constexpr size_t O_PMK = O_PBI + (size_t)MP * 64;
constexpr size_t O_PMV = O_PMK + (size_t)NBATCH * 256 * 512;
constexpr size_t O_PFC = O_PMV + (size_t)NBATCH * 256 * 512;
constexpr size_t O_SAK = O_PFC + (size_t)NBATCH * 2 * DFF;
constexpr size_t O_SAV = O_SAK + (size_t)MS * 512;
constexpr size_t O_SBK = O_SAV + (size_t)MS * 512;
constexpr size_t O_SBV = O_SBK + (size_t)MS * 128;
constexpr size_t O_SBI = O_SBV + (size_t)MS * 128;
constexpr size_t O_SFC = O_SBI + (size_t)MS * 64;
constexpr size_t O_END = O_SFC + (size_t)DB * 2 * DFF;
static_assert(O_END == 25536512, "output size");

constexpr size_t MiB = 1u << 20;
constexpr size_t WS_CTL = 0, CTL_ZERO_BYTES = 1 * MiB;
constexpr size_t WS_WIN = 1 * MiB;
constexpr size_t WS_WVA = 6 * MiB;
constexpr size_t WS_WO = 7 * MiB;
constexpr size_t WS_WMQ = 9 * MiB;
constexpr size_t WS_WMK = 10 * MiB;
constexpr size_t WS_WMV = 11 * MiB;
constexpr size_t WS_WMO = 12 * MiB;
constexpr size_t WS_WUP = 13 * MiB;
constexpr size_t WS_WDN = 24 * MiB;
constexpr size_t WS_AB = 31 * MiB;
constexpr size_t WS_MEMB = 64 * MiB;
constexpr size_t WS_MK = 66 * MiB;
constexpr size_t WS_MVT = 67 * MiB;
constexpr size_t WS_MKS = 68 * MiB;
constexpr size_t WS_MVTS = 70 * MiB;
constexpr size_t WS_QM = 72 * MiB;
constexpr size_t WS_WI = 89 * MiB;
constexpr size_t WS_Q2 = 90 * MiB;
constexpr size_t WS_KA = 123 * MiB;
constexpr size_t WS_VAT = 139 * MiB;
constexpr size_t WS_QI = 155 * MiB;
constexpr size_t WS_KB = 172 * MiB;
constexpr size_t WS_VB = 176 * MiB;
constexpr size_t WS_KI = 180 * MiB;
constexpr size_t WS_KAS = 182 * MiB;
constexpr size_t WS_VATS = 187 * MiB;
constexpr size_t WS_KBS = 192 * MiB;
constexpr size_t WS_VBS = 197 * MiB;
constexpr size_t WS_KIS = 202 * MiB;
constexpr size_t WS_HMID = 90 * MiB;
constexpr size_t WS_END = 206 * MiB;
static_assert(WS_HMID + (size_t)MT * DFF * 2 <= WS_KAS, "hmid overlay");
static_assert(WS_AB + (size_t)MT * D * 2 <= WS_MEMB && WS_QM + (size_t)MT * 512 * 2 <= WS_WI && WS_WI + (size_t)MT * 32 <= WS_Q2 && WS_Q2 + (size_t)MT * D * 2 <= WS_KA, "ws map");
static_assert(WS_QI + (size_t)MT * 512 * 2 <= WS_KB && WS_KAS + (size_t)(8 * AKS + 32) * 1024 <= WS_VATS && WS_VATS + (size_t)8 * 512 * AKS * 2 + 64 <= WS_KBS && WS_KBS + (size_t)8 * BKS * 256 <= WS_VBS && WS_KIS + (size_t)8 * BKS * 128 <= WS_END, "ws map 2");
constexpr int CW_TMO = 0, CW_CODE = 1, CW_BAR = 4096;
constexpr size_t CT_CSQ = 64 * 1024;
constexpr size_t CT_BQ = CT_CSQ + 2048;
constexpr size_t CT_CSU = 72 * 1024;
constexpr size_t CT_BU = 96 * 1024;
constexpr size_t CT_ST1 = 128 * 1024;
constexpr size_t CT_ST2 = 384 * 1024;
static_assert(CT_ST1 + (size_t)MT * 8 <= CT_ST2 && CT_ST2 + (size_t)MT * 8 <= CTL_ZERO_BYTES, "ctl map");

constexpr int RING_BYTES = 131072;
constexpr int SC_STRIDE = 8200;
constexpr int L_SEL = 131328;
constexpr int L_T5 = L_SEL + 16384;
constexpr int L_LUT = L_T5 + 1024;
constexpr int L_ABIAS = L_LUT + 256;
constexpr int L_XG = L_ABIAS + 6144;
constexpr int L_MISC = L_XG + 4096;
constexpr int LDS_BYTES = 163840;
static_assert(16 * SC_STRIDE <= L_SEL && L_MISC + 512 <= LDS_BYTES, "LDS map");

constexpr int NWAVES = 8;
#ifndef MK_N_LAUNCHES
#define MK_N_LAUNCHES 1
#endif
constexpr int N_PHASES = 10;
namespace pg8 {
#define PG8_LAS __attribute__((address_space(3)))
typedef unsigned short bf16_t;
constexpr int BM = 256, BK = 64, HALF = 128, HTB = HALF * BK * 2  , STAGE_BYTES = 8 * HTB, NXCD = 8, WGM = 8;
__host__ __device__ __forceinline__ int lds_byte(int r, int c) { const int st = (r >> 4) * 2 + (c >> 5), rr = r & 15, cc = c & 31, ob = rr * 64 + cc * 2; return st * 1024 + (ob ^ (((ob >> 9) & 1) << 5)); }
__host__ __device__ __forceinline__ void stage_rc(int b, int& R, int& C) { const int st = b / 1024, sb = b % 1024, swz = sb ^ (((sb >> 9) & 1) << 5); R = (st >> 1) * 16 + swz / 64; C = (st & 1) * 32 + (swz % 64) / 2; }
__host__ __device__ __forceinline__ int perm32(int rho) { const int n = rho >> 4, i = rho & 15; return 8 * (i >> 2) + 4 * n + (i & 3); }
struct Unit { int pm, pn, gid; };
__device__ __forceinline__ void tile_map(int L, int nM, int nN, int& pm, int& pn) {
    const int nwg = nM * nN; int wgid = L; { const int q = nwg / NXCD, r = nwg % NXCD, xcd = wgid % NXCD, off = wgid / NXCD; wgid = (xcd < r ? xcd * (q + 1) : r * (q + 1) + (xcd - r) * q) + off; }
    const int nig = WGM * nN, gid = wgid / nig, fm = gid * WGM, gsz = (nM - fm) < WGM ? (nM - fm) : WGM;
    pm = fm + ((wgid % nig) % gsz); pn = (wgid % nig) / gsz;
}
template <class Epi, class Sched, bool ALIGN_EPI = false, bool SP2 = false>
__device__ __forceinline__ void gemm_phase(PG8_LAS unsigned char* lds, const int K_, const Sched& S, const Epi& E) {
    const int tid = threadIdx.x, wid = __builtin_amdgcn_readfirstlane(tid >> 6), lane = tid & 63, wr = wid >> 2, wc = wid & 3, fr = lane & 15, fq = lane >> 4;
    const int K = K_, nt = K / BK;
    unsigned voffA[2], voffB[2];
#pragma unroll
    for (int i = 0; i < 2; ++i) { int R, C; stage_rc(tid * 16 + i * 8192, R, C); const int Rb = Epi::PERM ? ((R & ~31) + perm32(R & 31)) : R;
        voffA[i] = (unsigned)(R * K + C) * 2u; voffB[i] = (unsigned)(Rb * K + C) * 2u; }
    const size_t kstep = (size_t)(BK * 2);
    const size_t hstep = (size_t)HALF * K * 2;
    const unsigned ldsw = (unsigned)wid * 1024u;
    const int aoff = lds_byte(wr * 64 + fr, fq * 8), boff = lds_byte(wc * 32 + fr, fq * 8);
#define PG8_SA(b, h) (((b) * 2 + (h)) * HTB)
#define PG8_SB(b, h) ((4 + (b) * 2 + (h)) * HTB)
#define PG8_STAGE(bufoff, gbase, voff) do { _Pragma("unroll") for (int _i = 0; _i < 2; ++_i) \
        __builtin_amdgcn_global_load_lds((const unsigned*)((const char*)(gbase) + (voff)[_i]), (PG8_LAS unsigned*)(lds + (bufoff) + ldsw + _i * 8192), 16, 0, 0); } while (0)
#define PG8_LDA(dst, b, h) do { _Pragma("unroll") for (int m = 0; m < 4; ++m) _Pragma("unroll") for (int k = 0; k < 2; ++k) dst[m][k] = *(const PG8_LAS bf16x8*)(lds + PG8_SA(b, h) + aoff + m * 2048 + k * 1024); } while (0)
#define PG8_LDB(dst, b, h) do { _Pragma("unroll") for (int n = 0; n < 2; ++n) _Pragma("unroll") for (int k = 0; k < 2; ++k) dst[n][k] = *(const PG8_LAS bf16x8*)(lds + PG8_SB(b, h) + boff + n * 2048 + k * 1024); } while (0)
#define PG8_MMA(ai, bj, At, Bt) do { __builtin_amdgcn_s_setprio(1); _Pragma("unroll") for (int m = 0; m < 4; ++m) _Pragma("unroll") for (int n = 0; n < 2; ++n) _Pragma("unroll") for (int k = 0; k < 2; ++k) \
        acc[ai][bj][m][n] = __builtin_amdgcn_mfma_f32_16x16x32_bf16(Bt[n][k], At[m][k], acc[ai][bj][m][n], 0, 0, 0); __builtin_amdgcn_s_setprio(0); } while (0)
#define PG8_WAIT_V(n) asm volatile("s_waitcnt vmcnt(" #n ")" ::: "memory")
#define PG8_WAIT_L(n) asm volatile("s_waitcnt lgkmcnt(" #n ")" ::: "memory")
#define PG8_BAR __builtin_amdgcn_s_barrier()
#define PG8_SCHED __builtin_amdgcn_sched_barrier(0)
    Unit cur, nxt; int ui = 0;
    if (!S.next(0, cur)) return;
    f32x4 acc[2][2][4][2];
#pragma unroll
    for (int a = 0; a < 2; ++a)
#pragma unroll
        for (int b = 0; b < 2; ++b)
#pragma unroll
            for (int m = 0; m < 4; ++m)
#pragma unroll
                for (int n = 0; n < 2; ++n) acc[a][b][m][n] = (f32x4){0.f, 0.f, 0.f, 0.f};
    bf16x8 At[4][2], B0[2][2], B1[2][2];
    const char* cA; const char* cB; S.ptrs(cur, cA, cB);
    S.a_ready(cur);
    if constexpr (SP2) {
        PG8_STAGE(PG8_SB(0, 0), cB, voffB); PG8_STAGE(PG8_SB(0, 1), cB + hstep, voffB); PG8_STAGE(PG8_SA(0, 0), cA, voffA); PG8_STAGE(PG8_SA(0, 1), cA + hstep, voffA);
        if (wr == 1) PG8_BAR;
        PG8_WAIT_V(2); PG8_BAR;
        PG8_STAGE(PG8_SB(1, 0), cB + kstep, voffB); PG8_STAGE(PG8_SA(1, 0), cA + kstep, voffA); PG8_STAGE(PG8_SB(1, 1), cB + hstep + kstep, voffB);
        PG8_WAIT_V(6); PG8_BAR;
    } else {
        PG8_STAGE(PG8_SB(0, 0), cB, voffB); PG8_STAGE(PG8_SA(0, 0), cA, voffA); PG8_STAGE(PG8_SB(0, 1), cB + hstep, voffB); PG8_STAGE(PG8_SA(0, 1), cA + hstep, voffA);
        if (wr == 1) PG8_BAR;
        PG8_WAIT_V(4); PG8_BAR;
        PG8_STAGE(PG8_SB(1, 0), cB + kstep, voffB); PG8_STAGE(PG8_SA(1, 0), cA + kstep, voffA); PG8_STAGE(PG8_SB(1, 1), cB + hstep + kstep, voffB);
        PG8_WAIT_V(6); PG8_BAR;
    }
    for (;;) {
        const bool has_next = S.next(ui + 1, nxt);
        const char* nA = cA; const char* nB = cB; if (has_next) S.ptrs(nxt, nA, nB);
        for (int t = 0; t < nt; t += 2) {
            const bool last = (t == nt - 2);
            const char* a1 = cA + (size_t)(t + 1) * kstep;
            const char* a2 = last ? nA : cA + (size_t)(t + 2) * kstep; const char* b2 = last ? nB : cB + (size_t)(t + 2) * kstep;
            const char* a3 = a2 + kstep; const char* b3 = b2 + kstep;
            if (last && has_next) S.a_ready(nxt);
            if constexpr (SP2) {
            PG8_LDB(B0, 0, 0); PG8_LDB(B1, 0, 1); PG8_SCHED; PG8_LDA(At, 0, 0); PG8_STAGE(PG8_SA(1, 1), a1 + hstep, voffA);
            PG8_WAIT_V(8); PG8_WAIT_L(0); PG8_BAR; PG8_MMA(0, 0, At, B0); PG8_MMA(0, 1, At, B1); PG8_BAR; PG8_SCHED;
            PG8_LDA(At, 0, 1); PG8_STAGE(PG8_SB(0, 0), b2, voffB); PG8_STAGE(PG8_SB(0, 1), b2 + hstep, voffB); PG8_STAGE(PG8_SA(0, 0), a2, voffA);
            PG8_WAIT_V(8); PG8_WAIT_L(0); PG8_BAR; PG8_MMA(1, 0, At, B0); PG8_MMA(1, 1, At, B1); PG8_BAR; PG8_SCHED;
            PG8_LDB(B0, 1, 0); PG8_LDB(B1, 1, 1); PG8_SCHED; PG8_LDA(At, 1, 0); PG8_STAGE(PG8_SA(0, 1), a2 + hstep, voffA);
            PG8_WAIT_V(8); PG8_WAIT_L(0); PG8_BAR; PG8_MMA(0, 0, At, B0); PG8_MMA(0, 1, At, B1); PG8_BAR; PG8_SCHED;
            PG8_LDA(At, 1, 1); PG8_STAGE(PG8_SB(1, 0), b3, voffB); PG8_STAGE(PG8_SB(1, 1), b3 + hstep, voffB); PG8_STAGE(PG8_SA(1, 0), a3, voffA);
            PG8_WAIT_V(8); PG8_WAIT_L(0); PG8_BAR; PG8_MMA(1, 0, At, B0); PG8_MMA(1, 1, At, B1); PG8_BAR; PG8_SCHED;
            } else {
            PG8_LDB(B0, 0, 0); PG8_SCHED; PG8_LDA(At, 0, 0); PG8_STAGE(PG8_SA(1, 1), a1 + hstep, voffA);
            PG8_WAIT_L(8); PG8_BAR; PG8_WAIT_L(0); PG8_MMA(0, 0, At, B0); PG8_BAR; PG8_SCHED;
            PG8_LDB(B1, 0, 1); PG8_STAGE(PG8_SB(0, 0), b2, voffB);
            PG8_BAR; PG8_WAIT_L(0); PG8_MMA(0, 1, At, B1); PG8_BAR;
            PG8_LDA(At, 0, 1); PG8_STAGE(PG8_SA(0, 0), a2, voffA);
            PG8_BAR; PG8_WAIT_L(0); PG8_MMA(1, 0, At, B0); PG8_BAR; PG8_SCHED;
            PG8_STAGE(PG8_SB(0, 1), b2 + hstep, voffB);
            PG8_WAIT_V(6); PG8_BAR; PG8_MMA(1, 1, At, B1); PG8_BAR;
            PG8_LDB(B0, 1, 0); PG8_SCHED; PG8_LDA(At, 1, 0); PG8_STAGE(PG8_SA(0, 1), a2 + hstep, voffA);
            PG8_WAIT_L(8); PG8_BAR; PG8_WAIT_L(0); PG8_MMA(0, 0, At, B0); PG8_BAR; PG8_SCHED;
            PG8_LDB(B1, 1, 1); PG8_STAGE(PG8_SB(1, 0), b3, voffB);
            PG8_BAR; PG8_WAIT_L(0); PG8_MMA(0, 1, At, B1); PG8_BAR;
            PG8_LDA(At, 1, 1); PG8_STAGE(PG8_SA(1, 0), a3, voffA);
            PG8_BAR; PG8_WAIT_L(0); PG8_MMA(1, 0, At, B0); PG8_BAR; PG8_SCHED;
            PG8_STAGE(PG8_SB(1, 1), b3 + hstep, voffB);
            PG8_WAIT_V(6); PG8_BAR; PG8_MMA(1, 1, At, B1); PG8_BAR;
            }
        }
        if constexpr (ALIGN_EPI) { if (wr == 0) PG8_BAR; }
        if constexpr (!Epi::AFTER_DRAIN) { if constexpr (Epi::EDUP) E(acc, cur, wr, wc, fr, fq, lane); E(acc, cur, wr, wc, fr, fq, lane); S.done(cur); }
        if (!has_next) break;
#pragma unroll
        for (int a = 0; a < 2; ++a)
#pragma unroll
            for (int b = 0; b < 2; ++b)
#pragma unroll
                for (int m = 0; m < 4; ++m)
#pragma unroll
                    for (int n = 0; n < 2; ++n) acc[a][b][m][n] = (f32x4){0.f, 0.f, 0.f, 0.f};
        cur = nxt; cA = nA; cB = nB; ++ui;
        if constexpr (ALIGN_EPI) { if (wr == 1) PG8_BAR; }
    }
    PG8_WAIT_V(0);
    if constexpr (!ALIGN_EPI) { if (wr == 0) PG8_BAR; }
    PG8_BAR;
    if constexpr (Epi::AFTER_DRAIN) { E.fused(acc, cur, wr, wc, fr, fq, lds, wid, lane); S.done(cur); }
#undef PG8_SA
#undef PG8_SB
#undef PG8_STAGE
#undef PG8_LDA
#undef PG8_LDB
#undef PG8_MMA
#undef PG8_WAIT_V
#undef PG8_WAIT_L
#undef PG8_BAR
#undef PG8_SCHED
}}
#define RLX_AGENT __ATOMIC_RELAXED, __HIP_MEMORY_SCOPE_AGENT
#define LDS_WAIT() asm volatile("s_waitcnt lgkmcnt(0)" ::: "memory")
#define VM_WAIT() asm volatile("s_waitcnt vmcnt(0)" ::: "memory")
__device__ __forceinline__ unsigned long long rt() { return __builtin_amdgcn_s_memrealtime(); }
__device__ __forceinline__ unsigned f2bf(float f) { unsigned u = __builtin_bit_cast(unsigned, f); return (u + 0x7fffu + ((u >> 16) & 1u)) >> 16; }
__device__ __forceinline__ unsigned pk2(float lo, float hi) { return f2bf(lo) | (f2bf(hi) << 16); }
#define XB_TMO      128
#define XB_XCNT(j)  (256  + 64 * (j))
#define XB_XSUB(j)  (1280 + 64 * (j))
#define XB_XGEN(j)  (2304 + 64 * (j))
#define XB_TOP      3328
#define XB_TOPGEN   3392
#define XCD_BAR_WORDS 3456
#define XB_SPIN_CAP (1u << 18)

__device__ __forceinline__ unsigned xb_ld(unsigned* p)              { return __hip_atomic_load(p, __ATOMIC_RELAXED, __HIP_MEMORY_SCOPE_AGENT); }
__device__ __forceinline__ unsigned xb_add(unsigned* p, unsigned v) { return __hip_atomic_fetch_add(p, v, __ATOMIC_RELAXED, __HIP_MEMORY_SCOPE_AGENT); }
__device__ __forceinline__ unsigned xb_xcc_id() { return (unsigned)__builtin_amdgcn_s_getreg((3 << 11) | 20) & 0xFu; }
#define XB_SPIN(cond, bar) do { unsigned _sp = 0; while (cond) { __builtin_amdgcn_s_sleep(1); \
    if ((++_sp & 255u) == 0u) { if (xb_ld(&(bar)[XB_TMO])) break; if (_sp > XB_SPIN_CAP) { atomicAdd(&(bar)[XB_TMO], 1u); break; } } } } while (0)

struct XcdBarrier {
    unsigned* bar; unsigned x;
    volatile LAS unsigned* st;
};

__device__ __forceinline__ XcdBarrier xcd_barrier_post(unsigned* bar, volatile LAS unsigned* st) {
    XcdBarrier b; b.bar = bar; b.x = xb_xcc_id(); b.st = st;
    if (threadIdx.x == 0) (void)xb_add(&bar[XB_XCNT(b.x)], 1u);
    return b;
}
__device__ __forceinline__ void xcd_barrier_complete(unsigned* bar, unsigned x, unsigned& nloc, unsigned& nx) {
    const unsigned G = gridDim.x * gridDim.y * gridDim.z;
    unsigned sum, cnt, mine, sp = 0u;
    for (;;) {
        sum = 0u; cnt = 0u; mine = 0u;
#pragma unroll
        for (unsigned j = 0; j < 16; ++j) { const unsigned c = xb_ld(&bar[XB_XCNT(j)]); sum += c; cnt += (c > 0u) ? 1u : 0u; mine = (j == x) ? c : mine; }
        if (sum == G) break;
        __builtin_amdgcn_s_sleep(1);
        if ((++sp & 255u) == 0u) { if (xb_ld(&bar[XB_TMO])) break; if (sp > XB_SPIN_CAP) { atomicAdd(&bar[XB_TMO], 1u); break; } }
    }
    nloc = mine > 0u ? mine : 1u; nx = cnt > 0u ? cnt : 1u;
}

__device__ __forceinline__ void xcd_barrier(const XcdBarrier& b) {
    asm volatile("s_waitcnt vmcnt(0)" ::: "memory");
    __syncthreads();
    if (threadIdx.x == 0) {
        unsigned* bar = b.bar;
        __builtin_amdgcn_s_waitcnt(0);
        unsigned nloc = b.st[0], nx = b.st[1];
        if (nloc == 0u) { xcd_barrier_complete(bar, b.x, nloc, nx); b.st[0] = nloc; b.st[1] = nx; }
        const unsigned old = xb_add(&bar[XB_XSUB(b.x)], 1u);
        const unsigned gen = old / nloc;
        if (old + 1u == (gen + 1u) * nloc) {
            __builtin_amdgcn_fence(__ATOMIC_RELEASE, "agent");
            asm volatile("s_waitcnt vmcnt(0)" ::: "memory");
            const unsigned og = xb_add(&bar[XB_TOP], 1u);
            const unsigned tg = og / nx;
            if (og + 1u == (tg + 1u) * nx) xb_add(&bar[XB_TOPGEN], 1u);
            else XB_SPIN(xb_ld(&bar[XB_TOPGEN]) == tg, bar);
            __builtin_amdgcn_fence(__ATOMIC_ACQUIRE, "agent");
            xb_add(&bar[XB_XGEN(b.x)], 1u);
            asm volatile("s_waitcnt vmcnt(0)" ::: "memory");
        } else {
            XB_SPIN(xb_ld(&bar[XB_XGEN(b.x)]) == gen, bar);
            __builtin_amdgcn_fence(__ATOMIC_ACQUIRE, "agent");
            asm volatile("s_waitcnt vmcnt(0)" ::: "memory");
        }
    }
    __syncthreads();
}
typedef __bf16 bf16x2_t __attribute__((ext_vector_type(2)));
__device__ __forceinline__ unsigned cvtpk(float lo, float hi) { f32x2 v = {lo, hi}; bf16x2_t b = __builtin_convertvector(v, bf16x2_t); return __builtin_bit_cast(unsigned, b); }
__device__ __forceinline__ float bf2f(short x) { return __uint_as_float(((unsigned)(unsigned short)x) << 16); }
__device__ __forceinline__ void st_bf16x4(bf16* p, f32x4 v) { u32x2 w; w.x = cvtpk(v[0], v[1]); w.y = cvtpk(v[2], v[3]); *(u32x2*)p = w; }
__device__ __forceinline__ bf16x8 pack8(f32x4 a, f32x4 b) { u32x4 w; w.x = cvtpk(a[0], a[1]); w.y = cvtpk(a[2], a[3]); w.z = cvtpk(b[0], b[1]); w.w = cvtpk(b[2], b[3]); return __builtin_bit_cast(bf16x8, w); }
#define MFMA16(a, b, c) __builtin_amdgcn_mfma_f32_16x16x32_bf16((a), (b), (c), 0, 0, 0)
__device__ __forceinline__ float xor16(float v) { return __shfl_xor(v, 16); }
__device__ __forceinline__ float xor32(float v) { return __shfl_xor(v, 32); }
__device__ __forceinline__ float ror1(float v) { return __int_as_float(__builtin_amdgcn_update_dpp(0, __float_as_int(v), 0x121, 0xf, 0xf, false)); }
__device__ __forceinline__ float ror2(float v) { return __int_as_float(__builtin_amdgcn_update_dpp(0, __float_as_int(v), 0x122, 0xf, 0xf, false)); }
__device__ __forceinline__ float gelu_tanh(float x) { const float e = __builtin_amdgcn_exp2f(-2.3022081985f * (x + 0.044715f * x * x * x)); return x * __builtin_amdgcn_rcpf(1.0f + e); }
__device__ __forceinline__ s16x4 tr_read(const LAS unsigned char* p) { return __builtin_bit_cast(s16x4, __builtin_amdgcn_ds_read_tr16_b64_v4i16((LAS s16x4*)p)); }

struct Frame {
    LAS unsigned char* lds;
    volatile LAS unsigned* MISC;
    gu32* ctl;
    unsigned char* ws;
    const float* const* in;
    float* out;
    int tid, lane, wave, vcu, G;
};

__device__ __forceinline__ void tr_item(const float* W, int ldw, int n0, int nvalid, int k0, const float* ksc, bf16* dst, size_t dpitch, int drow, LAS float* scr, int lane) {
    f32x4 v[8];
#pragma unroll
    for (int i = 0; i < 8; ++i) { const int kk = 8 * i + (lane >> 3), n = n0 + 4 * (lane & 7);
        v[i] = (n < nvalid) ? *(const f32x4*)(W + (size_t)(k0 + kk) * ldw + n) : (f32x4){0.f, 0.f, 0.f, 0.f}; if (ksc) v[i] = v[i] * ksc[k0 + kk]; }
#pragma unroll
    for (int i = 0; i < 8; ++i) { LAS float* s = scr + (8 * i + (lane >> 3)) * 33 + 4 * (lane & 7); s[0] = v[i][0]; s[1] = v[i][1]; s[2] = v[i][2]; s[3] = v[i][3]; }
    LDS_WAIT(); asm volatile("" ::: "memory");
    const int c = lane & 7;
#pragma unroll
    for (int j = 0; j < 4; ++j) { const int n = (lane >> 3) + 8 * j; const LAS float* s = scr + (8 * c) * 33 + n;
        u32x4 o; o.x = cvtpk(s[0 * 33], s[1 * 33]); o.y = cvtpk(s[2 * 33], s[3 * 33]); o.z = cvtpk(s[4 * 33], s[5 * 33]); o.w = cvtpk(s[6 * 33], s[7 * 33]);
        *(u32x4*)(dst + (size_t)(drow + n) * dpitch + k0 + 8 * c) = o; }
    LDS_WAIT(); asm volatile("" ::: "memory");
}
__device__ __forceinline__ void cvt_seg(const float* src, bf16* dst, size_t total, size_t sb, size_t db, int gw, int NGW, int lane) {
    const size_t nit = total / 512;
    for (size_t it = gw; it < nit; it += NGW) { const size_t e = it * 512 + lane * 8; const f32x4 a = *(const f32x4*)(src + e), b = *(const f32x4*)(src + e + 4);
        u32x4 o; o.x = cvtpk(a[0], a[1]); o.y = cvtpk(a[2], a[3]); o.z = cvtpk(b[0], b[1]); o.w = cvtpk(b[2], b[3]);
        *(u32x4*)(dst + (e / sb) * db + (e % sb)) = o; }
}
__device__ __forceinline__ void csum_item(const float* W, int ldw, int n, int k0, const float* gk, const float* bk, float* cs, float* bv, int dest) {
    f32x4 w[32];
#pragma unroll
    for (int k = 0; k < 32; ++k) w[k] = *(const f32x4*)(W + (size_t)(k0 + k) * ldw + n);
    f32x4 s1 = {0.f, 0.f, 0.f, 0.f}, s2 = {0.f, 0.f, 0.f, 0.f};
#pragma unroll
    for (int k = 0; k < 32; ++k) { const float gg = gk[k0 + k], bb = bk[k0 + k];
#pragma unroll
        for (int j = 0; j < 4; ++j) { s1[j] += __uint_as_float(f2bf(gg * w[k][j]) << 16); s2[j] += bb * w[k][j]; } }
#pragma unroll
    for (int j = 0; j < 4; ++j) { atomicAdd(cs + dest + j, s1[j]); atomicAdd(bv + dest + j, s2[j]); }
}
__device__ __forceinline__ void p0_prologue(Frame& F, bool do_csum) {
    LAS float* scr = (LAS float*)(F.lds + F.wave * 16384);
    const int gw = F.vcu * NWAVES + F.wave, NGW = F.G * NWAVES, lane = F.lane;
    unsigned char* ws = F.ws;
    for (int it = gw; it < 16 * 91; it += NGW) { const int kb = it / 91, nb = it % 91, n0 = 32 * nb; bf16* dst = (bf16*)(ws + WS_WIN); int drow;
        if (n0 < 512) drow = n0; else if (n0 < 1024) drow = 1024 + (n0 - 512); else if (n0 < 1536) { dst = (bf16*)(ws + WS_WVA); drow = n0 - 1024; } else if (n0 < 2048) drow = 512 + (n0 - 1536);
        else if (n0 < 2304) drow = n0; else if (n0 < 2816) drow = 1536 + (n0 - 2304); else drow = 2304 + (n0 - 2816);
        tr_item(F.in[I_WIN], 2888, n0, 2888, 64 * kb, nullptr, dst, 1024, drow, scr, lane); }
    for (int it = gw; it < 320; it += NGW) *(u32x4*)(ws + WS_WIN + (size_t)2400 * 2048 + (size_t)it * 1024 + lane * 16) = (u32x4){0u, 0u, 0u, 0u};
    for (int it = gw; it < 16 * 32; it += NGW) tr_item(F.in[I_WO], 1024, 32 * (it % 32), 1024, 64 * (it / 32), nullptr, (bf16*)(ws + WS_WO), 1024, 32 * (it % 32), scr, lane);
    for (int it = gw; it < 16 * 16; it += NGW) tr_item(F.in[I_WMQ], 512, 32 * (it % 16), 512, 64 * (it / 16), F.in[I_G1], (bf16*)(ws + WS_WMQ), 1024, 32 * (it % 16), scr, lane);
    for (int it = gw; it < 16 * 16; it += NGW) tr_item(F.in[I_WMK], 512, 32 * (it % 16), 512, 64 * (it / 16), nullptr, (bf16*)(ws + WS_WMK), 1024, 32 * (it % 16), scr, lane);
    for (int it = gw; it < 16 * 16; it += NGW) tr_item(F.in[I_WMV], 512, 32 * (it % 16), 512, 64 * (it / 16), nullptr, (bf16*)(ws + WS_WMV), 1024, 32 * (it % 16), scr, lane);
    for (int it = gw; it < 8 * 32; it += NGW) tr_item(F.in[I_WMO], 1024, 32 * (it % 32), 1024, 64 * (it / 32), nullptr, (bf16*)(ws + WS_WMO), 512, 32 * (it % 32), scr, lane);
    for (int it = gw; it < 16 * 176; it += NGW) { const int kb = it / 176, n0 = 32 * (it % 176); const int nn = n0 < DFF ? n0 : n0 - DFF; const int drow = 256 * (nn / 128) + (nn % 128) + (n0 < DFF ? 0 : 128);
        tr_item(F.in[I_WUP], NUP, n0, NUP, 64 * kb, F.in[I_G2], (bf16*)(ws + WS_WUP), 1024, drow, scr, lane); }
    for (int it = gw; it < 44 * 32; it += NGW) tr_item(F.in[I_WDN], 1024, 32 * (it % 32), 1024, 64 * (it / 32), nullptr, (bf16*)(ws + WS_WDN), DFF, 32 * (it % 32), scr, lane);
    for (int it = gw; it < 8 * 128; it += NGW) { const int sb = it / 128, r = it % 128;
        tr_item(F.in[I_CAV] + (size_t)sb * 512 * 512, 512, 32 * (r % 16), 512, 64 * (r / 16), nullptr, (bf16*)(ws + WS_VATS) + (size_t)sb * 512 * AKS, AKS, 32 * (r % 16), scr, lane); }
    for (int it = gw; it < 8 * 64; it += NGW) { const int sb = it / 64, r = it % 64;
        tr_item(F.in[I_CMV] + (size_t)sb * 256 * 512, 512, 32 * (r % 16), 512, 64 * (r / 16), nullptr, (bf16*)(ws + WS_MVTS) + (size_t)sb * 512 * 256, 256, 32 * (r % 16), scr, lane); }
    cvt_seg(F.in[I_XP], (bf16*)(ws + WS_AB), (size_t)MP * D, (size_t)MP * D, 0, gw, NGW, lane);
    cvt_seg(F.in[I_XS], (bf16*)(ws + WS_AB) + (size_t)MP * D, (size_t)MS * D, (size_t)MS * D, 0, gw, NGW, lane);
    for (int it = gw; it < 256; it += NGW) *(u32x4*)(ws + WS_AB + (size_t)MROWS * 2048 + (size_t)it * 1024 + lane * 16) = (u32x4){0u, 0u, 0u, 0u};
    cvt_seg(F.in[I_MEM], (bf16*)(ws + WS_MEMB), (size_t)1024 * 1024, (size_t)1024 * 1024, 0, gw, NGW, lane);
    cvt_seg(F.in[I_CAK], (bf16*)(ws + WS_KAS), (size_t)8 * 512 * 512, (size_t)512 * 512, (size_t)AKS * 512, gw, NGW, lane);
    cvt_seg(F.in[I_CBK], (bf16*)(ws + WS_KBS), (size_t)8 * PAST * 128, (size_t)PAST * 128, (size_t)BKS * 128, gw, NGW, lane);
    cvt_seg(F.in[I_CBV], (bf16*)(ws + WS_VBS), (size_t)8 * PAST * 128, (size_t)PAST * 128, (size_t)BKS * 128, gw, NGW, lane);
    cvt_seg(F.in[I_CBI], (bf16*)(ws + WS_KIS), (size_t)8 * PAST * 64, (size_t)PAST * 64, (size_t)BKS * 64, gw, NGW, lane);
    cvt_seg(F.in[I_CMK], (bf16*)(ws + WS_MKS), (size_t)8 * 256 * 512, (size_t)8 * 256 * 512, 0, gw, NGW, lane);
    if (!do_csum) return;
    for (int it = gw; it < 64; it += NGW) { const int n = 256 * (it % 2) + 4 * lane; csum_item(F.in[I_WMQ], 512, n, 32 * (it / 2), F.in[I_G1], F.in[I_B1], (float*)(ws + CT_CSQ), (float*)(ws + CT_BQ), n); }
    for (int it = gw; it < 704; it += NGW) { const int n = 256 * (it % 22) + 4 * lane; const int nn = n < DFF ? n : n - DFF; const int dest = 256 * (nn / 128) + (nn % 128) + (n < DFF ? 0 : 128);
        csum_item(F.in[I_WUP], NUP, n, 32 * (it / 22), F.in[I_G2], F.in[I_B2], (float*)(ws + CT_CSU), (float*)(ws + CT_BU), dest); }
}

struct SchedPlain {
    int nM, nN, G, c; const char* A; const char* B; size_t rowbytes;
    __device__ __forceinline__ bool next(int i, pg8::Unit& u) const { const long L = (long)i * G + c; if (L >= (long)nM * nN) return false; pg8::tile_map((int)L, nM, nN, u.pm, u.pn); u.gid = 0; return true; }
    __device__ __forceinline__ void ptrs(const pg8::Unit& u, const char*& a, const char*& b) const { a = A + (size_t)u.pm * 256 * rowbytes; b = B + (size_t)u.pn * 256 * rowbytes; }
    __device__ __forceinline__ void a_ready(const pg8::Unit&) const {}
    __device__ __forceinline__ void done(const pg8::Unit&) const {}
};
struct SchedP1 {
    int G, c; const char *AB, *WIN, *WVA;
    __device__ __forceinline__ bool next(int i, pg8::Unit& u) const { long L = (long)i * G + c;
        if (L < 640) { pg8::tile_map((int)L, 64, 10, u.pm, u.pn); u.gid = 0; return true; } L -= 640;
        if (L < 128) { pg8::tile_map((int)L, 2, 64, u.pm, u.pn); u.gid = 1; return true; }
        return false; }
    __device__ __forceinline__ void ptrs(const pg8::Unit& u, const char*& a, const char*& b) const { const size_t t = (size_t)256 * 2048;
        if (u.gid == 0) { a = AB + u.pm * t; b = WIN + u.pn * t; } else { a = WVA + u.pm * t; b = AB + u.pn * t; } }
    __device__ __forceinline__ void a_ready(const pg8::Unit&) const {}
    __device__ __forceinline__ void done(const pg8::Unit&) const {}
};
struct SchedP4 {
    int G, c; const char *AB, *WMQ, *MEMB, *WMK, *WMV;
    __device__ __forceinline__ bool next(int i, pg8::Unit& u) const { long L = (long)i * G + c;
        if (L < 128) { pg8::tile_map((int)L, 64, 2, u.pm, u.pn); u.gid = 0; return true; } L -= 128;
        if (L < 8) { u.pm = (int)L & 3; u.pn = (int)L >> 2; u.gid = 2; return true; } L -= 8;
        if (L < 8) { u.pm = (int)L & 1; u.pn = (int)L >> 1; u.gid = 3; return true; }
        return false; }
    __device__ __forceinline__ void ptrs(const pg8::Unit& u, const char*& a, const char*& b) const { const size_t t = (size_t)256 * 2048;
        if (u.gid == 0) { a = AB + u.pm * t; b = WMQ + u.pn * t; } else if (u.gid == 2) { a = MEMB + u.pm * t; b = WMK + u.pn * t; } else { a = WMV + u.pm * t; b = MEMB + u.pn * t; } }
    __device__ __forceinline__ void a_ready(const pg8::Unit&) const {}
    __device__ __forceinline__ void done(const pg8::Unit&) const {}
};
struct SchedP5 {
    int G, c; const char* A; const char* B;
    __device__ __forceinline__ bool next(int i, pg8::Unit& u) const { const long L = (long)i * G + c; if (L >= 65 * 22) return false; pg8::tile_map((int)L, 65, 22, u.pm, u.pn); u.gid = 0; return true; }
    __device__ __forceinline__ void ptrs(const pg8::Unit& u, const char*& a, const char*& b) const { const long R0 = u.pm < 65 ? 254L * u.pm - 2 : (long)MP; a = A + R0 * 2048; b = B + (size_t)u.pn * 256 * 2048; }
    __device__ __forceinline__ void a_ready(const pg8::Unit&) const {}
    __device__ __forceinline__ void done(const pg8::Unit&) const {}
};

#define EPI_ROWS(R0) _Pragma("unroll") for (int ai = 0; ai < 2; ++ai) _Pragma("unroll") for (int m = 0; m < 4; ++m) { const int row = (R0) + 128 * ai + 64 * wr + 16 * m + fr;
#define EPI_COLS(C0) _Pragma("unroll") for (int bj = 0; bj < 2; ++bj) _Pragma("unroll") for (int n = 0; n < 2; ++n) { const int col = (C0) + 128 * bj + 32 * wc + 16 * n + 4 * fq; const f32x4 a4 = acc[ai][bj][m][n];

#ifndef EPI_DUP
#define EPI_DUP 0
#endif
struct EpiP1 {
    static constexpr bool PERM = false, AFTER_DRAIN = false, EDUP = (EPI_DUP & 2) != 0;
    unsigned char* ws; float* out;
    __device__ __forceinline__ void main_elem(int row, int col, f32x4 v) const {
        const bool smp = row >= MP; const int s = row - MP, sb = s >> 4, si = s & 15, b = row >> 12, t = row & 4095;
        if (col < 1024) { st_bf16x4((bf16*)(ws + WS_Q2) + (size_t)row * 1024 + col, v * QSCALE); }
        else if (col < 1536) { const int kc = col - 1024;
            if (!smp) { st_bf16x4((bf16*)(ws + WS_KA) + (size_t)row * 512 + kc, v); if (t >= 3584) *(f32x4*)(out + O_PAK + ((size_t)(b * 512 + t - 3584) * 512 + kc)) = v; }
            else { st_bf16x4((bf16*)(ws + WS_KAS) + ((size_t)(sb * AKS + 512 + si) * 512 + kc), v); *(f32x4*)(out + O_SAK + (size_t)s * 512 + kc) = v; } }
        else if (col < 2048) { st_bf16x4((bf16*)(ws + WS_QI) + (size_t)row * 512 + (col - 1536), v); }
        else if (col < 2176) { const int c2 = col - 2048;
            if (!smp) { st_bf16x4((bf16*)(ws + WS_KB) + (size_t)row * 128 + c2, v); *(f32x4*)(out + O_PBK + (size_t)row * 128 + c2) = v; }
            else { st_bf16x4((bf16*)(ws + WS_KBS) + ((size_t)(sb * BKS + PAST + si) * 128 + c2), v); *(f32x4*)(out + O_SBK + (size_t)s * 128 + c2) = v; } }
        else if (col < 2304) { const int c2 = col - 2176;
            if (!smp) { st_bf16x4((bf16*)(ws + WS_VB) + (size_t)row * 128 + c2, v); *(f32x4*)(out + O_PBV + (size_t)row * 128 + c2) = v; }
            else { st_bf16x4((bf16*)(ws + WS_VBS) + ((size_t)(sb * BKS + PAST + si) * 128 + c2), v); *(f32x4*)(out + O_SBV + (size_t)s * 128 + c2) = v; } }
        else if (col < 2368) { const int c3 = col - 2304;
            if (!smp) { st_bf16x4((bf16*)(ws + WS_KI) + (size_t)row * 64 + c3, v); *(f32x4*)(out + O_PBI + (size_t)row * 64 + c3) = v; }
            else { st_bf16x4((bf16*)(ws + WS_KIS) + ((size_t)(sb * BKS + PAST + si) * 64 + c3), v); *(f32x4*)(out + O_SBI + (size_t)s * 64 + c3) = v; } }
        else if (col < 2376) { *(f32x4*)((float*)(ws + WS_WI) + (size_t)row * 8 + (col - 2368)) = v * WISCALE; }
    }
    __device__ __forceinline__ void operator()(const f32x4 (&acc)[2][2][4][2], const pg8::Unit& u, int wr, int wc, int fr, int fq, int lane) const {
        if (u.gid == 0) {
            EPI_ROWS(256 * u.pm) if (row < MROWS) { EPI_COLS(256 * u.pn) main_elem(row, col, a4); } } }
        } else if (u.gid == 1) {
            EPI_ROWS(256 * u.pm) EPI_COLS(256 * u.pn)
                if (col < MP) { const int b = col >> 12, t = col & 4095; st_bf16x4((bf16*)(ws + WS_VAT) + ((size_t)(b * 512 + row) * 4096 + t), a4);
                    if (t >= 3584) { float* o = out + O_PAV + ((size_t)(b * 512 + t - 3584) * 512 + row); o[0] = a4[0]; o[512] = a4[1]; o[1024] = a4[2]; o[1536] = a4[3]; } }
                else if (col < MROWS) { const int s = col - MP, sb = s >> 4, si = s & 15; st_bf16x4((bf16*)(ws + WS_VATS) + ((size_t)(sb * 512 + row) * AKS + 512 + si), a4);
                    float* o = out + O_SAV + ((size_t)s * 512 + row); o[0] = a4[0]; o[512] = a4[1]; o[1024] = a4[2]; o[1536] = a4[3]; }
            } }
        }
    }
};
__device__ __forceinline__ void row_stats(const float* st, int row, float& mu, float& rs) { const f32x2 s = *(const f32x2*)(st + 2 * (size_t)row); mu = s.x * (1.f / D); const float var = s.y * (1.f / D) - mu * mu; rs = __builtin_amdgcn_rsqf(var + LN_EPS); }

struct EpiP3 {
    static constexpr bool PERM = false, AFTER_DRAIN = false, EDUP = false;
    const float* xp; bf16* AB; float* st; int dry;
    __device__ __forceinline__ void operator()(const f32x4 (&acc)[2][2][4][2], const pg8::Unit& u, int wr, int wc, int fr, int fq, int lane) const {
        if (dry) { float s_ = 0.f; _Pragma("unroll") for (int a_ = 0; a_ < 2; ++a_) _Pragma("unroll") for (int b_ = 0; b_ < 2; ++b_) _Pragma("unroll") for (int m_ = 0; m_ < 4; ++m_) _Pragma("unroll") for (int n_ = 0; n_ < 2; ++n_) s_ += (acc[a_][b_][m_][n_][0] + acc[a_][b_][m_][n_][1]) + (acc[a_][b_][m_][n_][2] + acc[a_][b_][m_][n_][3]); if (s_ == 1.2345e33f) st[0] = s_; return; }
        EPI_ROWS(256 * u.pm) { const float* x = xp + (size_t)row * D; float s = 0.f, q = 0.f;
            EPI_COLS(256 * u.pn) const f32x4 v = *(const f32x4*)(x + col) * ALPHA + a4; st_bf16x4(AB + (size_t)row * D + col, v);
                s += (v[0] + v[1]) + (v[2] + v[3]); q += (v[0] * v[0] + v[1] * v[1]) + (v[2] * v[2] + v[3] * v[3]); }
            s += xor16(s); s += xor32(s); q += xor16(q); q += xor32(q);
            if (fq == 0) { atomicAdd(st + 2 * (size_t)row, s); atomicAdd(st + 2 * (size_t)row + 1, q); } } }
    }
};
struct EpiP4a {
    static constexpr bool PERM = false, AFTER_DRAIN = false, EDUP = (EPI_DUP & 16) != 0;
    const float* st; const float* cs; const float* bq; bf16* QM; unsigned char* ws; float* out;
    __device__ __forceinline__ void operator()(const f32x4 (&acc)[2][2][4][2], const pg8::Unit& u, int wr, int wc, int fr, int fq, int lane) const {
        if (u.gid == 2) {
            EPI_ROWS(256 * u.pm) EPI_COLS(256 * u.pn) st_bf16x4((bf16*)(ws + WS_MK) + (size_t)row * 512 + col, a4); *(f32x4*)(out + O_PMK + (size_t)row * 512 + col) = a4; } }
            return; }
        if (u.gid == 3) {
            EPI_ROWS(256 * u.pm) EPI_COLS(256 * u.pn) const int b = col >> 8, mi = col & 255; st_bf16x4((bf16*)(ws + WS_MVT) + ((size_t)(b * 512 + row) * 256 + mi), a4);
                float* o = out + O_PMV + ((size_t)col * 512 + row); o[0] = a4[0]; o[512] = a4[1]; o[1024] = a4[2]; o[1536] = a4[3]; } }
            return; }
        EPI_ROWS(256 * u.pm) if (row < MROWS) { float mu, rs; row_stats(st, row, mu, rs);
            EPI_COLS(256 * u.pn) const f32x4 c4 = *(const f32x4*)(cs + col), b4 = *(const f32x4*)(bq + col); st_bf16x4(QM + (size_t)row * 512 + col, ((a4 - c4 * mu) * rs + b4) * QMSCALE); } } }
    }
};
__device__ __forceinline__ f32x4 ld_bf16x4(const bf16* p) { const u32x2 w = *(const u32x2*)p; return (f32x4){__uint_as_float(w.x << 16), __uint_as_float(w.x & 0xffff0000u), __uint_as_float(w.y << 16), __uint_as_float(w.y & 0xffff0000u)}; }
struct EpiRes {
    static constexpr bool PERM = false, AFTER_DRAIN = false, EDUP = false;
    bf16* AB; const float* st_old; const float* gam; const float* bet; float* Vout; float* st_new; int dry;
    __device__ __forceinline__ void operator()(const f32x4 (&acc)[2][2][4][2], const pg8::Unit& u, int wr, int wc, int fr, int fq, int lane) const {
        if (dry) { float s_ = 0.f; _Pragma("unroll") for (int a_ = 0; a_ < 2; ++a_) _Pragma("unroll") for (int b_ = 0; b_ < 2; ++b_) _Pragma("unroll") for (int m_ = 0; m_ < 4; ++m_) _Pragma("unroll") for (int n_ = 0; n_ < 2; ++n_) s_ += (acc[a_][b_][m_][n_][0] + acc[a_][b_][m_][n_][1]) + (acc[a_][b_][m_][n_][2] + acc[a_][b_][m_][n_][3]); if (s_ == 1.2345e33f) AB[0] = (bf16)1; return; }
        EPI_ROWS(256 * u.pm) { float mu, rs; row_stats(st_old, row, mu, rs); float s = 0.f, q = 0.f;
            EPI_COLS(256 * u.pn) const f32x4 vo = ld_bf16x4(AB + (size_t)row * D + col), g4 = *(const f32x4*)(gam + col), b4 = *(const f32x4*)(bet + col);
                const f32x4 v = ((vo - mu) * rs * g4 + b4) * ALPHA + a4;
                if (Vout) *(f32x4*)(Vout + (size_t)row * D + col) = v;
                else { st_bf16x4(AB + (size_t)row * D + col, v); s += (v[0] + v[1]) + (v[2] + v[3]); q += (v[0] * v[0] + v[1] * v[1]) + (v[2] * v[2] + v[3] * v[3]); } }
            if (!Vout) { s += xor16(s); s += xor32(s); q += xor16(q); q += xor32(q);
                if (fq == 0) { atomicAdd(st_new + 2 * (size_t)row, s); atomicAdd(st_new + 2 * (size_t)row + 1, q); } } } }
    }
};
struct EpiP5 {
    static constexpr bool PERM = false, AFTER_DRAIN = false, EDUP = (EPI_DUP & 128) != 0;
    const float* st; const float* cs; const float* bu; const float* wconv; const float* bconv; const float* hist; bf16* H; float* out; LAS unsigned char* lds; int dry;
    __device__ __forceinline__ void operator()(const f32x4 (&acc)[2][2][4][2], const pg8::Unit& u, int wr, int wc, int fr, int fq, int lane) const {
        if (dry) { float s_ = 0.f; _Pragma("unroll") for (int a_ = 0; a_ < 2; ++a_) _Pragma("unroll") for (int b_ = 0; b_ < 2; ++b_) _Pragma("unroll") for (int m_ = 0; m_ < 4; ++m_) _Pragma("unroll") for (int n_ = 0; n_ < 2; ++n_) s_ += (acc[a_][b_][m_][n_][0] + acc[a_][b_][m_][n_][1]) + (acc[a_][b_][m_][n_][2] + acc[a_][b_][m_][n_][3]); if (s_ == 1.2345e33f) out[0] = s_; return; }
        const bool smp = (u.pm == 65); const int R0 = smp ? MP : 254 * u.pm - 2;
        const int wcol = 256 * u.pn + 32 * wc + 4 * fq;
        const int hcol = 128 * u.pn + 32 * wc + 4 * fq;
        float mu[2][4], rs[2][4];
#pragma unroll
        for (int ai = 0; ai < 2; ++ai)
#pragma unroll
            for (int m = 0; m < 4; ++m) { int row = R0 + 128 * ai + 64 * wr + 16 * m + fr; row = row < 0 ? 0 : row; row_stats(st, row, mu[ai][m], rs[ai][m]); }
        LAS float* XG = (LAS float*)(lds + L_XG);
#pragma unroll
        for (int n = 0; n < 2; ++n) { const f32x4 cg = *(const f32x4*)(cs + wcol + 128 + 16 * n), bg = *(const f32x4*)(bu + wcol + 128 + 16 * n);
#pragma unroll
            for (int ai = 0; ai < 2; ++ai) { const f32x4 g3 = (acc[ai][1][3][n] - cg * mu[ai][3]) * rs[ai][3] + bg;
                if (fr >= 14) *(LAS f32x4*)(XG + ((ai * 2 + wr) * 2 + (fr - 14)) * 128 + 32 * wc + 16 * n + 4 * fq) = g3; } }
        asm volatile("s_waitcnt lgkmcnt(0)" ::: "memory"); __builtin_amdgcn_s_barrier(); asm volatile("" ::: "memory");
#pragma unroll
        for (int n = 0; n < 2; ++n) {
            const f32x4 cu = *(const f32x4*)(cs + wcol + 16 * n), b_u = *(const f32x4*)(bu + wcol + 16 * n), cg = *(const f32x4*)(cs + wcol + 128 + 16 * n), bg = *(const f32x4*)(bu + wcol + 128 + 16 * n);
            const int hc = hcol + 16 * n;
            const f32x4 w0 = *(const f32x4*)(wconv + hc), w1 = *(const f32x4*)(wconv + DFF + hc), w2 = *(const f32x4*)(wconv + 2 * DFF + hc), bc = *(const f32x4*)(bconv + hc);
#pragma unroll
            for (int ai = 0; ai < 2; ++ai) {
                f32x4 gprev = {0.f, 0.f, 0.f, 0.f};
#pragma unroll
                for (int m = 0; m < 4; ++m) {
                    const int loc = 128 * ai + 64 * wr + 16 * m + fr, row = R0 + loc;
                    const f32x4 g = (acc[ai][1][m][n] - cg * mu[ai][m]) * rs[ai][m] + bg;
                    const f32x4 uu = (acc[ai][0][m][n] - cu * mu[ai][m]) * rs[ai][m] + b_u;
                    f32x4 pv = gprev;
                    if (smp) { const int sb = 8 * ai + 4 * wr + m; pv = (f32x4){0.f, 0.f, 0.f, 0.f};
                        if (fr >= 14 && sb < 8) pv = *(const f32x4*)(hist + ((size_t)(sb * 2 + (fr - 14)) * DFF + hc)); }
                    else if (m == 0) { const int pg = ai * 2 + wr - 1;
                        pv = (f32x4){0.f, 0.f, 0.f, 0.f}; if (fr >= 14 && pg >= 0) pv = *(LAS f32x4*)(XG + (pg * 2 + (fr - 14)) * 128 + 32 * wc + 16 * n + 4 * fq); }
                    f32x4 g1, g2;
#pragma unroll
                    for (int j = 0; j < 4; ++j) { const float a1 = ror1(g[j]), p1 = ror1(pv[j]), a2 = ror2(g[j]), p2 = ror2(pv[j]); g1[j] = fr >= 1 ? a1 : p1; g2[j] = fr >= 2 ? a2 : p2; }
                    if (!smp) { const int t = row & 4095; if (t == 0) { g1 = (f32x4){0.f, 0.f, 0.f, 0.f}; g2 = g1; } else if (t == 1) g2 = (f32x4){0.f, 0.f, 0.f, 0.f}; }
                    const f32x4 gc = bc + w0 * g2 + w1 * g1 + w2 * g;
                    f32x4 h; h[0] = uu[0] * gelu_tanh(gc[0]); h[1] = uu[1] * gelu_tanh(gc[1]); h[2] = uu[2] * gelu_tanh(gc[2]); h[3] = uu[3] * gelu_tanh(gc[3]);
                    const bool valid = smp ? (row < MROWS) : (loc >= 2 && row < MP);
                    if (valid) { st_bf16x4(H + (size_t)row * DFF + hc, h);
                        if (!smp) { const int t = row & 4095; if (t >= 4094) *(f32x4*)(out + O_PFC + ((size_t)((row >> 12) * 2 + (t - 4094)) * DFF + hc)) = g; }
                        else { const int s = row - MP, si = s & 15; if (si >= 14) *(f32x4*)(out + O_SFC + ((size_t)((s >> 4) * 2 + (si - 14)) * DFF + hc)) = g; } }
                    gprev = g;
                }
            }
        }
    }
};
template <int NT, int UNR>
__device__ __forceinline__ void skinny_mma(const bf16* Arow, int K, const bf16* const (&Bt)[NT], f32x4 (&acc)[NT], int lane) {
    asm volatile("" : "+v"(lane));
    const int c16 = lane & 15, g = lane >> 4;
    const bf16* ap = Arow + (size_t)c16 * K + 8 * g; const bf16* bp[NT];
#pragma unroll
    for (int j = 0; j < NT; ++j) { bp[j] = Bt[j] + (size_t)c16 * K + 8 * g; acc[j] = (f32x4){0.f, 0.f, 0.f, 0.f}; }
#pragma unroll 1
    for (int k0 = 0; k0 < K; k0 += 32 * UNR) {
        bf16x8 a[UNR], b[NT][UNR];
#pragma unroll
        for (int u = 0; u < UNR; ++u) { a[u] = *(const bf16x8*)(ap + k0 + 32 * u);
#pragma unroll
            for (int j = 0; j < NT; ++j) b[j][u] = *(const bf16x8*)(bp[j] + k0 + 32 * u); }
#pragma unroll
        for (int u = 0; u < UNR; ++u)
#pragma unroll
            for (int j = 0; j < NT; ++j) acc[j] = MFMA16(b[j][u], a[u], acc[j]);
    }
}
__device__ __forceinline__ void smp_p1(Frame& F, int s) {
    unsigned char* ws = F.ws; const int lane = F.lane, fr = lane & 15, fq = lane >> 4, w = F.wave, srow = 16 * w + fr, row = MP + srow;
    const bf16* A = (const bf16*)(ws + WS_AB) + (size_t)(MP + 16 * w) * D;
    f32x4 acc[2];
    if (s < 80) { const bf16* const Bt[2] = {(const bf16*)(ws + WS_WIN) + (size_t)(32 * s) * D, (const bf16*)(ws + WS_WIN) + (size_t)(32 * s + 16) * D};
        skinny_mma<2, 8>(A, D, Bt, acc, lane);
        EpiP1 E{ws, F.out};
#pragma unroll
        for (int j = 0; j < 2; ++j) E.main_elem(row, 32 * s + 16 * j + 4 * fq, acc[j]);
    } else { const int n0 = 32 * (s - 80);
        const bf16* const Bt[2] = {(const bf16*)(ws + WS_WVA) + (size_t)n0 * D, (const bf16*)(ws + WS_WVA) + (size_t)(n0 + 16) * D};
        skinny_mma<2, 8>(A, D, Bt, acc, lane);
        bf16* vt = (bf16*)(ws + WS_VATS) + (size_t)(w * 512) * AKS + 512 + fr;
#pragma unroll
        for (int j = 0; j < 2; ++j) { const int n = n0 + 16 * j + 4 * fq; *(f32x4*)(F.out + O_SAV + (size_t)srow * 512 + n) = acc[j];
#pragma unroll
            for (int r = 0; r < 4; ++r) vt[(size_t)(n + r) * AKS] = (bf16)(cvtpk(acc[j][r], 0.f) & 0xffffu); }
    }
}
__device__ __forceinline__ void smp_p3(Frame& F, int s) {
    unsigned char* ws = F.ws; const int lane = F.lane, fr = lane & 15, fq = lane >> 4, w = F.wave, srow = 16 * w + fr, row = MP + srow;
    const bf16* const Bt[2] = {(const bf16*)(ws + WS_WO) + (size_t)(32 * s) * D, (const bf16*)(ws + WS_WO) + (size_t)(32 * s + 16) * D};
    f32x4 acc[2]; skinny_mma<2, 8>((const bf16*)(ws + WS_Q2) + (size_t)(MP + 16 * w) * D, D, Bt, acc, lane);
    float sm = 0.f, q = 0.f;
#pragma unroll
    for (int j = 0; j < 2; ++j) { const int col = 32 * s + 16 * j + 4 * fq; const f32x4 v = *(const f32x4*)(F.in[I_XS] + (size_t)srow * D + col) * ALPHA + acc[j];
        st_bf16x4((bf16*)(ws + WS_AB) + (size_t)row * D + col, v);
        sm += (v[0] + v[1]) + (v[2] + v[3]); q += (v[0] * v[0] + v[1] * v[1]) + (v[2] * v[2] + v[3] * v[3]); }
    sm += xor16(sm); sm += xor32(sm); q += xor16(q); q += xor32(q);
    float* st = (float*)(ws + CT_ST1);
    if (fq == 0) { atomicAdd(st + 2 * (size_t)row, sm); atomicAdd(st + 2 * (size_t)row + 1, q); }
}
__device__ __forceinline__ void smp_p4(Frame& F, int s) {
    unsigned char* ws = F.ws; const int lane = F.lane, fr = lane & 15, fq = lane >> 4, w = F.wave, row = MP + 16 * w + fr;
    const bf16* const Bt[2] = {(const bf16*)(ws + WS_WMQ) + (size_t)(32 * s) * D, (const bf16*)(ws + WS_WMQ) + (size_t)(32 * s + 16) * D};
    f32x4 acc[2]; skinny_mma<2, 8>((const bf16*)(ws + WS_AB) + (size_t)(MP + 16 * w) * D, D, Bt, acc, lane);
    float mu, rs; row_stats((const float*)(ws + CT_ST1), row, mu, rs);
#pragma unroll
    for (int j = 0; j < 2; ++j) { const int col = 32 * s + 16 * j + 4 * fq; const f32x4 c4 = *(const f32x4*)((const float*)(ws + CT_CSQ) + col), b4 = *(const f32x4*)((const float*)(ws + CT_BQ) + col);
        st_bf16x4((bf16*)(ws + WS_QM) + (size_t)row * 512 + col, ((acc[j] - c4 * mu) * rs + b4) * QMSCALE); }
}
__device__ __forceinline__ void smp_res(Frame& F, int s, const bf16* A, int K, const bf16* Wt, const float* st_old, const float* gam, const float* bet, bf16* AB, float* Vout, float* st_new) {
    const int lane = F.lane, fr = lane & 15, fq = lane >> 4, w = F.wave, row = MP + 16 * w + fr;
    const bf16* const Bt[2] = {Wt + (size_t)(32 * s) * K, Wt + (size_t)(32 * s + 16) * K};
    f32x4 acc[2]; skinny_mma<2, 8>(A + (size_t)(MP + 16 * w) * K, K, Bt, acc, lane);
    float mu, rs; row_stats(st_old, row, mu, rs); float sm = 0.f, q = 0.f;
#pragma unroll
    for (int j = 0; j < 2; ++j) { const int col = 32 * s + 16 * j + 4 * fq;
        const f32x4 vo = ld_bf16x4(AB + (size_t)row * D + col), g4 = *(const f32x4*)(gam + col), b4 = *(const f32x4*)(bet + col);
        const f32x4 v = ((vo - mu) * rs * g4 + b4) * ALPHA + acc[j];
        if (Vout) *(f32x4*)(Vout + (size_t)row * D + col) = v;
        else { st_bf16x4(AB + (size_t)row * D + col, v); sm += (v[0] + v[1]) + (v[2] + v[3]); q += (v[0] * v[0] + v[1] * v[1]) + (v[2] * v[2] + v[3] * v[3]); } }
    if (!Vout) { sm += xor16(sm); sm += xor32(sm); q += xor16(q); q += xor32(q);
        if (fq == 0) { atomicAdd(st_new + 2 * (size_t)row, sm); atomicAdd(st_new + 2 * (size_t)row + 1, q); } }
}
__device__ __forceinline__ void smp_p7(Frame& F, int s) {
    unsigned char* ws = F.ws; const int lane = F.lane, fr = lane & 15, fq = lane >> 4, w = F.wave, srow = 16 * w + fr, row = MP + srow;
    const int hc0 = 32 * s, wrow = 256 * (hc0 >> 7) + (hc0 & 127);
    const bf16* W = (const bf16*)(ws + WS_WUP);
    const bf16* const Bt[4] = {W + (size_t)wrow * D, W + (size_t)(wrow + 16) * D, W + (size_t)(wrow + 128) * D, W + (size_t)(wrow + 144) * D};
    f32x4 acc[4]; skinny_mma<4, 4>((const bf16*)(ws + WS_AB) + (size_t)(MP + 16 * w) * D, D, Bt, acc, lane);
    float mu, rs; row_stats((const float*)(ws + CT_ST2), row, mu, rs);
    const float* cs = (const float*)(ws + CT_CSU); const float* bu = (const float*)(ws + CT_BU); const float* wconv = F.in[I_WCONV]; const float* bconv = F.in[I_BCONV]; const float* hist = F.in[I_FFN];
#pragma unroll
    for (int j = 0; j < 2; ++j) { const int wc = wrow + 16 * j + 4 * fq, hc = hc0 + 16 * j + 4 * fq;
        const f32x4 uu = (acc[j] - *(const f32x4*)(cs + wc) * mu) * rs + *(const f32x4*)(bu + wc);
        const f32x4 g = (acc[2 + j] - *(const f32x4*)(cs + wc + 128) * mu) * rs + *(const f32x4*)(bu + wc + 128);
        f32x4 pv = {0.f, 0.f, 0.f, 0.f}; if (fr >= 14) pv = *(const f32x4*)(hist + ((size_t)(w * 2 + (fr - 14)) * DFF + hc));
        const f32x4 w0 = *(const f32x4*)(wconv + hc), w1 = *(const f32x4*)(wconv + DFF + hc), w2 = *(const f32x4*)(wconv + 2 * DFF + hc), bc = *(const f32x4*)(bconv + hc);
        f32x4 h;
#pragma unroll
        for (int r = 0; r < 4; ++r) { const float a1 = ror1(g[r]), p1 = ror1(pv[r]), a2 = ror2(g[r]), p2 = ror2(pv[r]); const float g1 = fr >= 1 ? a1 : p1, g2 = fr >= 2 ? a2 : p2;
            h[r] = uu[r] * gelu_tanh(bc[r] + w0[r] * g2 + w1[r] * g1 + w2[r] * g[r]); }
        st_bf16x4((bf16*)(ws + WS_HMID) + (size_t)row * DFF + hc, h);
        if (fr >= 14) *(f32x4*)(F.out + O_SFC + ((size_t)(w * 2 + (fr - 14)) * DFF + hc)) = g; }
}
template <int NQT>
__device__ __forceinline__ void band_unit(const bf16* Qp, const bf16* Kp, const bf16* VTp, int pv, int nkeys, int key0pos, int qpos0, bf16* Op, const LAS float* ab, int lane) {
    asm volatile("" : "+v"(lane));
    const int c16 = lane & 15, g = lane >> 4;
    bf16x8 qf[NQT][2];
#pragma unroll
    for (int nt = 0; nt < NQT; ++nt)
#pragma unroll
        for (int ks = 0; ks < 2; ++ks) qf[nt][ks] = *(const bf16x8*)(Qp + (size_t)(16 * nt + c16) * 1024 + 32 * ks + 8 * g);
    f32x4 O[4][NQT]; f32x4 negm[NQT]; float lsum[NQT];
#pragma unroll
    for (int nt = 0; nt < NQT; ++nt) { negm[nt] = (f32x4){0.f, 0.f, 0.f, 0.f}; lsum[nt] = 0.f;
#pragma unroll
        for (int mt = 0; mt < 4; ++mt) O[mt][nt] = (f32x4){0.f, 0.f, 0.f, 0.f}; }
    const int nblk = (nkeys + 31) >> 5;
    for (int kb = 0; kb < nblk; ++kb) {
        const bf16* kr = Kp + (size_t)(32 * kb + c16) * 512 + 8 * g;
        bf16x8 ka[2][2];
#pragma unroll
        for (int tl = 0; tl < 2; ++tl)
#pragma unroll
            for (int ks = 0; ks < 2; ++ks) ka[tl][ks] = *(const bf16x8*)(kr + (size_t)tl * 16 * 512 + 32 * ks);
        const bf16* vr = VTp + (size_t)c16 * pv + 32 * kb + 4 * g;
        s16x4 vlo[4], vhi[4];
#pragma unroll
        for (int mt = 0; mt < 4; ++mt) { vlo[mt] = *(const s16x4*)(vr + (size_t)16 * mt * pv); vhi[mt] = *(const s16x4*)(vr + (size_t)16 * mt * pv + 16); }
        f32x4 S[2][NQT];
#pragma unroll
        for (int tl = 0; tl < 2; ++tl)
#pragma unroll
            for (int nt = 0; nt < NQT; ++nt) { S[tl][nt] = MFMA16(ka[tl][0], qf[nt][0], negm[nt]); S[tl][nt] = MFMA16(ka[tl][1], qf[nt][1], S[tl][nt]); }
        const int kp0 = key0pos + 32 * kb;
        if (kp0 + 31 + 64 > qpos0) {
#pragma unroll
            for (int tl = 0; tl < 2; ++tl)
#pragma unroll
                for (int nt = 0; nt < NQT; ++nt)
#pragma unroll
                    for (int r = 0; r < 4; ++r) { int i = (qpos0 + 16 * nt + c16) - (kp0 + 16 * tl + 4 * g + r) + 64; i = i > 191 ? 191 : i; i = i < 0 ? 0 : i; S[tl][nt][r] += ab[i]; }
        }
        if (32 * kb + 32 > nkeys) {
#pragma unroll
            for (int tl = 0; tl < 2; ++tl)
#pragma unroll
                for (int nt = 0; nt < NQT; ++nt)
#pragma unroll
                    for (int r = 0; r < 4; ++r) if (32 * kb + 16 * tl + 4 * g + r >= nkeys) S[tl][nt][r] = -INFINITY;
        }
        const bool first = (kb == 0);
#pragma unroll
        for (int nt = 0; nt < NQT; ++nt) {
            float bm = fmaxf(fmaxf(fmaxf(S[0][nt][0], S[0][nt][1]), fmaxf(S[0][nt][2], S[0][nt][3])), fmaxf(fmaxf(S[1][nt][0], S[1][nt][1]), fmaxf(S[1][nt][2], S[1][nt][3])));
            bm = fmaxf(bm, xor16(bm)); bm = fmaxf(bm, xor32(bm));
            if (first || __any(bm > 8.f)) {
                const float dl = first ? bm : fmaxf(bm, 0.f);
                negm[nt] = negm[nt] - dl; S[0][nt] = S[0][nt] - dl; S[1][nt] = S[1][nt] - dl;
                if (!first) { const float f = __builtin_amdgcn_exp2f(-dl); lsum[nt] *= f;
#pragma unroll
                    for (int mt = 0; mt < 4; ++mt) O[mt][nt] = O[mt][nt] * f; }
            }
#pragma unroll
            for (int tl = 0; tl < 2; ++tl)
#pragma unroll
                for (int r = 0; r < 4; ++r) S[tl][nt][r] = __builtin_amdgcn_exp2f(S[tl][nt][r]);
            lsum[nt] += ((S[0][nt][0] + S[0][nt][1]) + (S[0][nt][2] + S[0][nt][3])) + ((S[1][nt][0] + S[1][nt][1]) + (S[1][nt][2] + S[1][nt][3]));
        }
        bf16x8 pB[NQT];
#pragma unroll
        for (int nt = 0; nt < NQT; ++nt) pB[nt] = pack8(S[0][nt], S[1][nt]);
#pragma unroll
        for (int mt = 0; mt < 4; ++mt) { const bf16x8 va = (bf16x8){vlo[mt][0], vlo[mt][1], vlo[mt][2], vlo[mt][3], vhi[mt][0], vhi[mt][1], vhi[mt][2], vhi[mt][3]};
#pragma unroll
            for (int nt = 0; nt < NQT; ++nt) O[mt][nt] = MFMA16(va, pB[nt], O[mt][nt]); }
    }
#pragma unroll
    for (int nt = 0; nt < NQT; ++nt) { float l = lsum[nt]; l += xor16(l); l += xor32(l); const float inv = 1.0f / l;
#pragma unroll
        for (int mt = 0; mt < 4; ++mt) st_bf16x4(Op + (size_t)(16 * nt + c16) * 1024 + 16 * mt + 4 * g, O[mt][nt] * inv); }
}

__device__ __forceinline__ unsigned lut_bucket(const LAS unsigned char* lut, int rel) { rel = rel < -64 ? -64 : rel; rel = rel > 191 ? 191 : rel; return lut[rel + 64]; }
__device__ __forceinline__ void dsa_unit(LAS unsigned char* lds, const bf16* Q2, bf16* Oq, const bf16* QI, const float* WI, int rowq0, int L, int qpos0, const bf16* KIp, const bf16* KBp, const bf16* VBp, int qbase, int npw, int wave, int lane) {
    asm volatile("" : "+v"(lane));
    int c16 = lane & 15, g = lane >> 4;
    const LAS unsigned char* lut = lds + L_LUT; const LAS float* t5 = (const LAS float*)(lds + L_T5);
#ifndef DSA_NO_A
#ifndef DSA_DUP
#define DSA_DUP 0
#endif
#pragma unroll 1
    for (int rep_ = 0; rep_ < ((DSA_DUP & 1) ? 2 : 1); ++rep_) {
        const f32x4 w0 = *(const f32x4*)(WI + (size_t)(rowq0 + c16) * 8), w1 = *(const f32x4*)(WI + (size_t)(rowq0 + c16) * 8 + 4);
        const float wi[8] = {w0[0], w0[1], w0[2], w0[3], w1[0], w1[1], w1[2], w1[3]};
        bf16x8 bq[8][2]; float lo[8], hi[8];
#pragma unroll
        for (int h = 0; h < 8; ++h) { lo[h] = wi[h] >= 0.f ? 0.f : -INFINITY; hi[h] = wi[h] >= 0.f ? INFINITY : 0.f;
#pragma unroll
            for (int ks = 0; ks < 2; ++ks) { const bf16x8 raw = *(const bf16x8*)(QI + (size_t)(rowq0 + c16) * 512 + h * 64 + 32 * ks + 8 * g); u32x4 w;
                w.x = cvtpk(bf2f(raw[0]) * wi[h], bf2f(raw[1]) * wi[h]); w.y = cvtpk(bf2f(raw[2]) * wi[h], bf2f(raw[3]) * wi[h]);
                w.z = cvtpk(bf2f(raw[4]) * wi[h], bf2f(raw[5]) * wi[h]); w.w = cvtpk(bf2f(raw[6]) * wi[h], bf2f(raw[7]) * wi[h]); bq[h][ks] = __builtin_bit_cast(bf16x8, w); } }
        const int ntile = L >> 4;
        typedef _Float16 h4 __attribute__((ext_vector_type(4)));
        bf16x8 ca[2][2];
#pragma unroll
        for (int j = 0; j < 2; ++j) { int tt = wave + 8 * j; tt = tt < ntile ? tt : ntile - 1; const bf16* kp = KIp + (size_t)(16 * tt + c16) * 64 + 8 * g; ca[j][0] = *(const bf16x8*)kp; ca[j][1] = *(const bf16x8*)(kp + 32); }
#pragma unroll 1
        for (int t = wave; t < ntile; t += 16) {
            bf16x8 na[2][2];
#pragma unroll
            for (int j = 0; j < 2; ++j) { int tt = t + 16 + 8 * j; tt = tt < ntile ? tt : ntile - 1; const bf16* kp = KIp + (size_t)(16 * tt + c16) * 64 + 8 * g; na[j][0] = *(const bf16x8*)kp; na[j][1] = *(const bf16x8*)(kp + 32); }
#pragma unroll
            for (int j = 0; j < 2; ++j) {
                f32x4 sc = {0.f, 0.f, 0.f, 0.f};
#pragma unroll
                for (int h = 0; h < 8; ++h) { f32x4 y = MFMA16(ca[j][0], bq[h][0], ((f32x4){0.f, 0.f, 0.f, 0.f})); y = MFMA16(ca[j][1], bq[h][1], y);
#pragma unroll
                    for (int r = 0; r < 4; ++r) sc[r] += __builtin_amdgcn_fmed3f(y[r], lo[h], hi[h]); }
                h4 hv; hv[0] = (_Float16)sc[0]; hv[1] = (_Float16)sc[1]; hv[2] = (_Float16)sc[2]; hv[3] = (_Float16)sc[3];
                const int tt = t + 8 * j;
                if (tt < ntile) *(LAS h4*)(lds + c16 * SC_STRIDE + (16 * tt + 4 * g) * 2) = hv;
            }
#pragma unroll
            for (int j = 0; j < 2; ++j) { ca[j][0] = na[j][0]; ca[j][1] = na[j][1]; }
        }
    }
#endif
    __syncthreads();
    asm volatile("" : "+v"(lane)); c16 = lane & 15; g = lane >> 4;
    const int cnt = L < 256 ? L : 256;
#ifndef DSA_NO_B
#pragma unroll 1
    for (int qq_ = 0; qq_ < ((DSA_DUP & 2) ? 2 * npw : npw); ++qq_) { const int qq = (DSA_DUP & 2) ? (qq_ >> 1) : qq_;
        const int q = qbase + npw * wave + qq, qpos = qpos0 + q;
        LAS unsigned* sel = (LAS unsigned*)(lds + L_SEL) + q * 256;
        if (L <= 256) {
            for (int j = lane; j < 256; j += 64) { const int idx = j < L ? j : 0; sel[j] = (unsigned)idx | (lut_bucket(lut, qpos - idx) << 16); }
        } else {
            const LAS unsigned short* srow = (const LAS unsigned short*)(lds + q * SC_STRIDE);
            const int nreg = (L + 63) >> 6;
            unsigned u[64];
#pragma unroll
            for (int i = 0; i < 64; ++i) { const int key = i * 64 + lane; unsigned v = 0u;
                if (i < nreg && key < L) { const unsigned b = srow[key]; v = (b & 0x8000u) ? (~b & 0xffffu) : (b | 0x8000u); }
                u[i] = v; }
            bool fast = false; unsigned Ts = 0u; int cfull = 0;
            if (nreg > 16) {
                int ns = 0, rs;
#define SMP_PASS(ST) do { _Pragma("unroll") for (int j = 0; j < 8; ++j) if (j * ST < nreg) { const int rem = L - 64 * j * ST; ns += rem < 64 ? rem : 64; } \
                    rs = (358 * ns) / L + 4; rs = rs < ns ? rs : ns; \
                    _Pragma("unroll 1") for (int bit = 15; bit >= 0; --bit) { const unsigned cand = Ts | (1u << bit); int c = 0; \
                        _Pragma("unroll") for (int j = 0; j < 8; ++j) if (j * ST < nreg) c += __builtin_popcountll(__ballot(u[j * ST] >= cand)); \
                        if (c >= rs) Ts = cand; } } while (0)
                if (nreg > 32) SMP_PASS(8); else SMP_PASS(4);
#undef SMP_PASS
#pragma unroll
                for (int ch = 0; ch < 8; ++ch) if (8 * ch < nreg) {
#pragma unroll
                    for (int i = 0; i < 8; ++i) cfull += __builtin_popcountll(__ballot(u[8 * ch + i] >= Ts)); }
                fast = (cfull >= 256 && cfull <= 512);
            }
            if (fast) {
                LAS unsigned* surv = (LAS unsigned*)(lds + q * SC_STRIDE);
                int base = 0;
#pragma unroll
                for (int ch = 0; ch < 8; ++ch) if (8 * ch < nreg) {
#pragma unroll
                    for (int i = 0; i < 8; ++i) { const unsigned v = u[8 * ch + i]; const bool take = v >= Ts; const unsigned long long mt = __ballot(take);
                        const int pos = base + (int)__builtin_amdgcn_mbcnt_hi((unsigned)(mt >> 32), __builtin_amdgcn_mbcnt_lo((unsigned)mt, 0u));
                        if (take) surv[pos] = (v << 12) | (unsigned)(4095 - ((8 * ch + i) * 64 + lane));
                        base += __builtin_popcountll(mt); } }
                unsigned sv[8];
#pragma unroll
                for (int j = 0; j < 8; ++j) { const int ix = j * 64 + lane; sv[j] = ix < cfull ? surv[ix] : 0u; }
                unsigned T = 0u;
#pragma unroll 1
                for (int bit = 27; bit >= 0; --bit) { const unsigned cand = T | (1u << bit); int c = 0;
#pragma unroll
                    for (int j = 0; j < 8; ++j) c += __builtin_popcountll(__ballot(sv[j] >= cand));
                    if (c >= 256) T = cand; }
                base = 0;
#pragma unroll
                for (int j = 0; j < 8; ++j) { const bool take = sv[j] >= T; const unsigned long long mt = __ballot(take);
                    const int pos = base + (int)__builtin_amdgcn_mbcnt_hi((unsigned)(mt >> 32), __builtin_amdgcn_mbcnt_lo((unsigned)mt, 0u));
                    if (take) { const int idx = 4095 - (int)(sv[j] & 4095u); sel[pos] = (unsigned)idx | (lut_bucket(lut, qpos - idx) << 16); }
                    base += __builtin_popcountll(mt); }
            } else {
            unsigned T = 0u;
#pragma unroll 1
            for (int bit = 15; bit >= 0; --bit) { const unsigned cand = T | (1u << bit); int c = 0;
#pragma unroll
                for (int ch = 0; ch < 8; ++ch) if (8 * ch < nreg) {
#pragma unroll
                    for (int i = 0; i < 8; ++i) c += __builtin_popcountll(__ballot(u[8 * ch + i] >= cand)); }
                if (c >= 256) T = cand; }
            int cgt = 0;
#pragma unroll
            for (int ch = 0; ch < 8; ++ch) if (8 * ch < nreg) {
#pragma unroll
                for (int i = 0; i < 8; ++i) cgt += __builtin_popcountll(__ballot(u[8 * ch + i] > T)); }
            const int need = 256 - cgt; int base = 0, eqs = 0;
#pragma unroll
            for (int ch = 0; ch < 8; ++ch) if (8 * ch < nreg) {
#pragma unroll
                for (int i = 0; i < 8; ++i) { const unsigned v = u[8 * ch + i]; const bool eq = (v == T);
                    const unsigned long long meq = __ballot(eq);
                    const int erank = eqs + (int)__builtin_amdgcn_mbcnt_hi((unsigned)(meq >> 32), __builtin_amdgcn_mbcnt_lo((unsigned)meq, 0u));
                    const bool take = (v > T) || (eq && erank < need);
                    const unsigned long long mt = __ballot(take);
                    const int pos = base + (int)__builtin_amdgcn_mbcnt_hi((unsigned)(mt >> 32), __builtin_amdgcn_mbcnt_lo((unsigned)mt, 0u));
                    if (take) { const int idx = (8 * ch + i) * 64 + lane; sel[pos] = (unsigned)idx | (lut_bucket(lut, qpos - idx) << 16); }
                    base += __builtin_popcountll(mt); eqs += __builtin_popcountll(meq); } }
            }
        }
    }
    if (npw == 1) __syncthreads();
#endif
#ifndef DSA_NO_C
    asm volatile("" : "+v"(lane)); c16 = lane & 15; g = lane >> 4;
    LAS unsigned char* vbuf = lds + (2 * wave) * SC_STRIDE;
#pragma unroll 1
    for (int qq_ = 0; qq_ < ((DSA_DUP & 4) ? 2 * npw : npw); ++qq_) { const int qq = ((DSA_DUP & 4) ? (qq_ >> 1) : qq_); bf16* Oe = ((DSA_DUP & 4) && !(qq_ & 1)) ? (bf16*)((unsigned char*)Oq + ((size_t)116 << 20)) : Oq;
        const int q = qbase + npw * wave + qq, row = rowq0 + q;
        const LAS unsigned* sel = (const LAS unsigned*)(lds + L_SEL) + q * 256;
        const int head = c16;
        bf16x8 qf[4];
#pragma unroll
        for (int ks = 0; ks < 4; ++ks) { qf[ks] = (bf16x8){0, 0, 0, 0, 0, 0, 0, 0};
            if (head < 8 && (head >> 2) == (ks >> 1)) qf[ks] = *(const bf16x8*)(Q2 + (size_t)row * 1024 + 512 + head * 64 + 32 * (ks & 1) + 8 * g); }
        f32x4 S[16];
        unsigned ek[16];
#pragma unroll
        for (int kt = 0; kt < 16; ++kt) ek[kt] = sel[kt * 16 + c16] & 0xffffu;
#pragma unroll
        for (int grp = 0; grp < 4; ++grp) {
            bf16x8 kf[4][4];
#pragma unroll
            for (int j = 0; j < 4; ++j) { const bf16* kp = KBp + (size_t)ek[4 * grp + j] * 128 + 8 * g;
#pragma unroll
                for (int ks = 0; ks < 4; ++ks) kf[j][ks] = *(const bf16x8*)(kp + 32 * ks); }
#pragma unroll
            for (int j = 0; j < 4; ++j) { f32x4 s = {0.f, 0.f, 0.f, 0.f};
#pragma unroll
                for (int ks = 0; ks < 4; ++ks) s = MFMA16(kf[j][ks], qf[ks], s);
                S[4 * grp + j] = s; }
            __builtin_amdgcn_sched_barrier(0);
        }
        float mx = -INFINITY;
#pragma unroll
        for (int kt = 0; kt < 16; ++kt)
#pragma unroll
            for (int r = 0; r < 4; ++r) { const int j = kt * 16 + 4 * g + r; const unsigned e = sel[j]; float s = S[kt][r] + t5[(e >> 16) * 8 + (head & 7)]; s = j < cnt ? s : -INFINITY; S[kt][r] = s; mx = fmaxf(mx, s); }
        mx = fmaxf(mx, xor16(mx)); mx = fmaxf(mx, xor32(mx));
        float l = 0.f;
#pragma unroll
        for (int kt = 0; kt < 16; ++kt)
#pragma unroll
            for (int r = 0; r < 4; ++r) { const float p = __builtin_amdgcn_exp2f(S[kt][r] - mx); S[kt][r] = p; l += p; }
        l += xor16(l); l += xor32(l);
        f32x4 O[8];
#pragma unroll
        for (int mt = 0; mt < 8; ++mt) O[mt] = (f32x4){0.f, 0.f, 0.f, 0.f};
        u32x4 vst[8];
#pragma unroll
        for (int i = 0; i < 8; ++i) { const unsigned e = sel[4 * i + g] & 0xffffu; vst[i] = *(const u32x4*)(VBp + (size_t)e * 128 + c16 * 8); }
#pragma unroll
        for (int t = 0; t < 8; ++t) {
#pragma unroll
            for (int i = 0; i < 8; ++i) *(LAS u32x4*)(vbuf + (4 * i + g) * 288 + c16 * 16) = vst[i];
            if (t < 7) {
#pragma unroll
                for (int i = 0; i < 8; ++i) { const unsigned e = sel[32 * (t + 1) + 4 * i + g] & 0xffffu; vst[i] = *(const u32x4*)(VBp + (size_t)e * 128 + c16 * 8); } }
            const bf16x8 pB = pack8(S[2 * t], S[2 * t + 1]);
            const LAS unsigned char* vb = vbuf + (4 * g + (c16 >> 2)) * 288 + (c16 & 3) * 8;
#pragma unroll
            for (int mt = 0; mt < 8; ++mt) { const s16x4 lo4 = tr_read(vb + mt * 32), hi4 = tr_read(vb + 16 * 288 + mt * 32);
                const bf16x8 va = (bf16x8){lo4[0], lo4[1], lo4[2], lo4[3], hi4[0], hi4[1], hi4[2], hi4[3]};
                O[mt] = MFMA16(va, pB, O[mt]); }
            __builtin_amdgcn_sched_barrier(0);
        }
        const float inv = 1.0f / l;
#pragma unroll
        for (int mt = 0; mt < 8; ++mt) if (head < 8 && (mt >> 2) == (head >> 2)) st_bf16x4(Oe + (size_t)row * 1024 + 512 + head * 64 + 16 * (mt & 3) + 4 * g, O[mt] * inv);
    }
#endif
    __syncthreads();
}

__device__ __forceinline__ void p2_attention(Frame& F, bf16* Oall) {
    unsigned char* ws = F.ws; const int tid = F.tid, lane = F.lane, wave = F.wave;
    { LAS float* t5 = (LAS float*)(F.lds + L_T5); LAS unsigned char* lut = F.lds + L_LUT; LAS float* ab = (LAS float*)(F.lds + L_ABIAS);
      if (tid < 256) { t5[tid] = F.in[I_T5][tid] * LOG2E;
          const int rel = tid - 64, n = rel < 0 ? -rel : rel; int bk;
          if (n < 8) bk = n; else { int v = 8 + (int)(2.0f * __log2f((float)n * 0.125f) + 1e-4f); bk = v > 15 ? 15 : v; }
          lut[tid] = (unsigned char)((rel < 0 ? 16 : 0) + bk); }
      for (int i = tid; i < 8 * 192; i += NWAVES * 64) { const int h = i / 192, j = i % 192; const int jj = j > 128 ? 128 : j;
          ab[i] = (F.in[I_AREL][jj * 8 + h] - F.in[I_AREL][128 * 8 + h]) * LOG2E; }
      __syncthreads(); }
    bf16* Q2 = (bf16*)(ws + WS_Q2);
    for (int slot = F.vcu; slot < 256; slot += F.G) {
        const int b = slot >> 6, c = slot & 63;
#ifndef NO_BAND4
#ifndef BAND_DUP
#define BAND_DUP 0
#endif
        for (int rb_ = 0; rb_ < (BAND_DUP ? 2 : 1); ++rb_) { const int kc0 = c > 8 ? c - 8 : 0, h = wave;
          band_unit<4>(Q2 + (size_t)(b * 4096 + 64 * c) * 1024 + h * 64, (const bf16*)(ws + WS_KA) + (size_t)(b * 4096 + 64 * kc0) * 512 + h * 64,
                       (const bf16*)(ws + WS_VAT) + (size_t)(b * 512 + h * 64) * 4096 + 64 * kc0, 4096, 64 * (c - kc0 + 1), 64 * kc0, 64 * c,
                       ((BAND_DUP && rb_ == 0) ? (bf16*)((unsigned char*)Oall + ((size_t)116 << 20)) : Oall) + (size_t)(b * 4096 + 64 * c) * 1024 + h * 64, (const LAS float*)(F.lds + L_ABIAS) + h * 192, lane); }
#endif
#ifndef NO_DSA
        { const int p = c >> 1, s2 = c & 1;
#pragma unroll 1
          for (int k = 0; k < 4; ++k) { const int cc = (k < 2) ? p : 63 - p, ss = 2 * s2 + (k & 1);
              dsa_unit(F.lds, Q2, Oall, (const bf16*)(ws + WS_QI), (const float*)(ws + WS_WI), b * 4096 + 64 * cc + 16 * ss, 64 * (cc + 1), 64 * cc + 16 * ss,
                       (const bf16*)(ws + WS_KI) + (size_t)b * 4096 * 64, (const bf16*)(ws + WS_KB) + (size_t)b * 4096 * 128, (const bf16*)(ws + WS_VB) + (size_t)b * 4096 * 128, 0, 2, wave, lane); } }
#endif
#ifndef NO_SAMPLE
        if (slot < 16) { const int sb = slot >> 1;
            dsa_unit(F.lds, Q2, Oall, (const bf16*)(ws + WS_QI), (const float*)(ws + WS_WI), MP + 16 * sb, BKS, PAST,
                     (const bf16*)(ws + WS_KIS) + (size_t)sb * BKS * 64, (const bf16*)(ws + WS_KBS) + (size_t)sb * BKS * 128, (const bf16*)(ws + WS_VBS) + (size_t)sb * BKS * 128, 8 * (slot & 1), 1, wave, lane); }
        else if (slot < 24) { const int sb = slot - 16, h = wave;
            band_unit<1>(Q2 + (size_t)(MP + 16 * sb) * 1024 + h * 64, (const bf16*)(ws + WS_KAS) + (size_t)sb * AKS * 512 + h * 64,
                         (const bf16*)(ws + WS_VATS) + (size_t)(sb * 512 + h * 64) * AKS, AKS, AKS, 0, 512,
                         Oall + (size_t)(MP + 16 * sb) * 1024 + h * 64, (const LAS float*)(F.lds + L_ABIAS) + h * 192, lane); }
#endif
    }
}

__device__ __forceinline__ void mem_stage(LAS unsigned char* lds, const bf16* Kp, const bf16* VTp, int tid) {
#pragma unroll
    for (int i = 0; i < 8; ++i) { const int ci = i * 512 + tid, row = ci >> 4, ch = ci & 15;
        const u32x4 v = *(const u32x4*)(Kp + (size_t)row * 512 + ch * 8); *(LAS u32x4*)(lds + row * 256 + ((ch ^ (row & 15)) << 4)) = v; }
#pragma unroll
    for (int i = 0; i < 8; ++i) { const int ci = i * 512 + tid, d = ci >> 5, ch = ci & 31;
        const u32x4 v = *(const u32x4*)(VTp + (size_t)d * 256 + ch * 8); *(LAS u32x4*)(lds + 65536 + d * 512 + ((ch * 16) ^ ((d & 15) << 4))) = v; }
}
__device__ __forceinline__ void mem_pass(const LAS unsigned char* lds, const bf16* QM, bf16* OM, int row0, int h, int lane) {
    asm volatile("" : "+v"(lane));
    const int c16 = lane & 15, g = lane >> 4;
    bf16x8 qf[4];
#pragma unroll
    for (int ks = 0; ks < 4; ++ks) qf[ks] = *(const bf16x8*)(QM + (size_t)(row0 + c16) * 512 + h * 128 + 32 * ks + 8 * g);
    f32x4 S[16]; float mx = -INFINITY;
#pragma unroll
    for (int kt = 0; kt < 16; ++kt) { const LAS unsigned char* kr = lds + (16 * kt + c16) * 256; f32x4 s = {0.f, 0.f, 0.f, 0.f};
#pragma unroll
        for (int ks = 0; ks < 4; ++ks) s = MFMA16(*(const LAS bf16x8*)(kr + (((4 * ks + g) ^ c16) << 4)), qf[ks], s);
        S[kt] = s; mx = fmaxf(mx, fmaxf(fmaxf(s[0], s[1]), fmaxf(s[2], s[3]))); }
    mx = fmaxf(mx, xor16(mx)); mx = fmaxf(mx, xor32(mx));
    float l = 0.f;
#pragma unroll
    for (int kt = 0; kt < 16; ++kt)
#pragma unroll
        for (int r = 0; r < 4; ++r) { const float p = __builtin_amdgcn_exp2f(S[kt][r] - mx); S[kt][r] = p; l += p; }
    l += xor16(l); l += xor32(l);
    f32x4 O[8];
#pragma unroll
    for (int mt = 0; mt < 8; ++mt) O[mt] = (f32x4){0.f, 0.f, 0.f, 0.f};
#pragma unroll
    for (int t = 0; t < 8; ++t) { const bf16x8 pB = pack8(S[2 * t], S[2 * t + 1]);
#pragma unroll
        for (int mt = 0; mt < 8; ++mt) { const LAS unsigned char* vr = lds + 65536 + (16 * mt + c16) * 512;
            const s16x4 lo4 = *(const LAS s16x4*)(vr + ((64 * t + 8 * g) ^ (c16 << 4))), hi4 = *(const LAS s16x4*)(vr + ((64 * t + 32 + 8 * g) ^ (c16 << 4)));
            const bf16x8 va = (bf16x8){lo4[0], lo4[1], lo4[2], lo4[3], hi4[0], hi4[1], hi4[2], hi4[3]};
            O[mt] = MFMA16(va, pB, O[mt]); } }
    const float inv = 1.0f / l;
#pragma unroll
    for (int mt = 0; mt < 8; ++mt) st_bf16x4(OM + (size_t)(row0 + c16) * 512 + h * 128 + 16 * mt + 4 * g, O[mt] * inv);
}
__device__ __forceinline__ void p4b_memattn(Frame& F, bf16* OM) {
    unsigned char* ws = F.ws; const bf16* QM = (const bf16*)(ws + WS_QM);
    for (int slot = F.vcu; slot < 256; slot += F.G) {
        { const int rb = slot >> 2, h = slot & 3, b = rb >> 4;
          mem_stage(F.lds, (const bf16*)(ws + WS_MK) + (size_t)b * 256 * 512 + h * 128, (const bf16*)(ws + WS_MVT) + (size_t)(b * 512 + h * 128) * 256, F.tid);
          __syncthreads();
          mem_pass(F.lds, QM, OM, 256 * rb + 32 * F.wave, h, F.lane); mem_pass(F.lds, QM, OM, 256 * rb + 32 * F.wave + 16, h, F.lane);
          __syncthreads(); }
        if (slot < 32) { const int sb = slot >> 2, h = slot & 3;
          mem_stage(F.lds, (const bf16*)(ws + WS_MKS) + (size_t)sb * 256 * 512 + h * 128, (const bf16*)(ws + WS_MVTS) + (size_t)(sb * 512 + h * 128) * 256, F.tid);
          __syncthreads();
          if (F.wave == 0) mem_pass(F.lds, QM, OM, MP + 16 * sb, h, F.lane);
          __syncthreads(); }
    }
}
__device__ __forceinline__ void p7_ln3(Frame& F, float* outp) {
    const int gw = F.vcu * NWAVES + F.wave, NGW = F.G * NWAVES; const float* g3 = F.in[I_G3]; const float* b3 = F.in[I_B3];
    for (int row = gw; row < MROWS; row += NGW) { const f32x4* xr = (const f32x4*)(F.out + (size_t)row * D) + F.lane; f32x4* yr = (f32x4*)(outp + (size_t)row * D) + F.lane; f32x4 v[4]; float s = 0.f;
#pragma unroll
        for (int j = 0; j < 4; ++j) { v[j] = xr[64 * j]; s += (v[j][0] + v[j][1]) + (v[j][2] + v[j][3]); }
#pragma unroll
        for (int o = 1; o < 64; o <<= 1) s += __shfl_xor(s, o);
        const float mean = s * (1.f / D); float s2 = 0.f;
#pragma unroll
        for (int j = 0; j < 4; ++j) { v[j] = v[j] - mean; s2 += (v[j][0] * v[j][0] + v[j][1] * v[j][1]) + (v[j][2] * v[j][2] + v[j][3] * v[j][3]); }
#pragma unroll
        for (int o = 1; o < 64; o <<= 1) s2 += __shfl_xor(s2, o);
        const float rstd = 1.f / sqrtf(s2 * (1.f / D) + LN_EPS);
#pragma unroll
        for (int j = 0; j < 4; ++j) { const f32x4 gg = *((const f32x4*)g3 + F.lane + 64 * j), bb = *((const f32x4*)b3 + F.lane + 64 * j); yr[64 * j] = v[j] * rstd * gg + bb; } }
}
struct Args { const float* in[N_IN]; float* out; unsigned char* ws; int ph_lo, ph_hi, li, pad; };
static_assert(sizeof(Args) == N_IN * 8 + 16 + 16, "Args has no padding");

__global__ void __launch_bounds__(NWAVES * 64, 2) fwd_megakernel(Args args) {
    extern __shared__ __attribute__((aligned(16))) unsigned char lds[];
    Frame F;
    F.lds = (LAS unsigned char*)lds;
    F.MISC = (volatile LAS unsigned*)(F.lds + L_MISC);
    F.tid = threadIdx.x; F.lane = F.tid & 63; F.wave = __builtin_amdgcn_readfirstlane(F.tid >> 6);
    F.G = gridDim.x; { const int bx = blockIdx.x; F.vcu = (F.G % 8 == 0) ? (bx % 8) * (F.G / 8) + bx / 8 : bx; }
    F.ws = args.ws; F.ctl = (gu32*)(args.ws + WS_CTL); F.in = args.in; F.out = args.out;
    unsigned char* ws = args.ws;
    for (int u = F.tid; u < 128; u += NWAVES * 64) ((LAS unsigned*)(F.lds + L_MISC))[u] = 0u;
    __syncthreads();
    const bool one_launch = (args.ph_hi - args.ph_lo) > 1;
    XcdBarrier bar; bar.bar = (unsigned*)(F.ctl + CW_BAR); bar.x = 0; bar.st = nullptr;
    if (one_launch) bar = xcd_barrier_post((unsigned*)(F.ctl + CW_BAR), F.MISC + 8);
    const int lo = args.ph_lo, hi = args.ph_hi;
#ifndef PH_MASK
#define PH_MASK 0x3ff
#endif
#define IN(k) (((PH_MASK >> (k)) & 1) && lo <= (k) && (k) < hi)
#define SEAM(k) do { if (IN(k) && IN((k) + 1)) xcd_barrier(bar); } while (0)
#ifndef DUP_MASK
#define DUP_MASK 0
#endif
#define DUP(k) ((DUP_MASK >> (k)) & 1)
    bf16* const dummy = (bf16*)(ws + WS_END);
    const int bx = (int)blockIdx.x;

    if (IN(0)) { if (DUP(0)) p0_prologue(F, false); p0_prologue(F, true); SEAM(0); }

    if (IN(1)) {
        SchedP1 S{F.G, bx, (const char*)(ws + WS_AB), (const char*)(ws + WS_WIN), (const char*)(ws + WS_WVA)};
        EpiP1 E{ws, F.out};
        if (DUP(1)) pg8::gemm_phase<EpiP1, SchedP1, true, true>(F.lds, 1024, S, E);
        pg8::gemm_phase<EpiP1, SchedP1, true, true>(F.lds, 1024, S, E);
        for (int s = F.G - 1 - bx; s < 96; s += F.G) smp_p1(F, s);
        SEAM(1);
    }
    if (IN(2)) { if (DUP(2)) p2_attention(F, dummy); p2_attention(F, (bf16*)(ws + WS_Q2)); SEAM(2); }

    if (IN(3)) {
        SchedPlain S{64, 4, F.G, bx, (const char*)(ws + WS_Q2), (const char*)(ws + WS_WO), 2048};
        EpiP3 E{F.in[I_XP], (bf16*)(ws + WS_AB), (float*)(ws + CT_ST1), 0};
        if (DUP(3)) { EpiP3 E2 = E; E2.dry = 1; pg8::gemm_phase<EpiP3, SchedPlain, true, true>(F.lds, 1024, S, E2); }
        pg8::gemm_phase<EpiP3, SchedPlain, true, true>(F.lds, 1024, S, E);
        for (int s = F.G - 1 - bx; s < 32; s += F.G) smp_p3(F, s);
        SEAM(3);
    }
    if (IN(4)) {
        SchedP4 S{F.G, bx, (const char*)(ws + WS_AB), (const char*)(ws + WS_WMQ), (const char*)(ws + WS_MEMB), (const char*)(ws + WS_WMK), (const char*)(ws + WS_WMV)};
        EpiP4a E{(const float*)(ws + CT_ST1), (const float*)(ws + CT_CSQ), (const float*)(ws + CT_BQ), (bf16*)(ws + WS_QM), ws, F.out};
        if (DUP(4)) pg8::gemm_phase<EpiP4a, SchedP4, true, true>(F.lds, 1024, S, E);
        pg8::gemm_phase<EpiP4a, SchedP4, true, true>(F.lds, 1024, S, E);
        for (int s = F.G - 1 - bx; s < 16; s += F.G) smp_p4(F, s);
        SEAM(4);
    }
    if (IN(5)) { if (DUP(5)) p4b_memattn(F, dummy); p4b_memattn(F, (bf16*)(ws + WS_QM)); SEAM(5); }

    if (IN(6)) {
        SchedPlain S{64, 4, F.G, bx, (const char*)(ws + WS_QM), (const char*)(ws + WS_WMO), 1024};
        EpiRes E{(bf16*)(ws + WS_AB), (const float*)(ws + CT_ST1), F.in[I_G1], F.in[I_B1], nullptr, (float*)(ws + CT_ST2), 0};
        if (DUP(6)) { EpiRes E2 = E; E2.dry = 1; pg8::gemm_phase<EpiRes, SchedPlain, true, true>(F.lds, 512, S, E2); }
        pg8::gemm_phase<EpiRes, SchedPlain, true, true>(F.lds, 512, S, E);
        for (int s = F.G - 1 - bx; s < 32; s += F.G) smp_res(F, s, (const bf16*)(ws + WS_QM), 512, (const bf16*)(ws + WS_WMO), (const float*)(ws + CT_ST1), F.in[I_G1], F.in[I_B1], (bf16*)(ws + WS_AB), nullptr, (float*)(ws + CT_ST2));
        SEAM(6);
    }
    if (IN(7)) {
        SchedP5 S{F.G, bx, (const char*)(ws + WS_AB), (const char*)(ws + WS_WUP)};
        EpiP5 E{(const float*)(ws + CT_ST2), (const float*)(ws + CT_CSU), (const float*)(ws + CT_BU), F.in[I_WCONV], F.in[I_BCONV], F.in[I_FFN], (bf16*)(ws + WS_HMID), F.out, F.lds, 0};
        if (DUP(7)) { EpiP5 E2 = E; E2.dry = 1; pg8::gemm_phase<EpiP5, SchedP5, true, true>(F.lds, 1024, S, E2); }
        pg8::gemm_phase<EpiP5, SchedP5, true, true>(F.lds, 1024, S, E);
        for (int s = F.G - 1 - bx; s < 88; s += F.G) smp_p7(F, s);
        SEAM(7);
    }
    if (IN(8)) {
        SchedPlain S{64, 4, F.G, bx, (const char*)(ws + WS_HMID), (const char*)(ws + WS_WDN), (size_t)DFF * 2};
        EpiRes E{(bf16*)(ws + WS_AB), (const float*)(ws + CT_ST2), F.in[I_G2], F.in[I_B2], F.out, nullptr, 0};
        if (DUP(8)) { EpiRes E2 = E; E2.dry = 1; pg8::gemm_phase<EpiRes, SchedPlain, true, true>(F.lds, DFF, S, E2); }
        pg8::gemm_phase<EpiRes, SchedPlain, true, true>(F.lds, DFF, S, E);
        for (int s = F.G - 1 - bx; s < 32; s += F.G) smp_res(F, s, (const bf16*)(ws + WS_HMID), DFF, (const bf16*)(ws + WS_WDN), (const float*)(ws + CT_ST2), F.in[I_G2], F.in[I_B2], (bf16*)(ws + WS_AB), F.out, nullptr);
        SEAM(8);
    }
    if (IN(9)) { if (DUP(9)) p7_ln3(F, (float*)(ws + WS_HMID)); p7_ln3(F, F.out); }
#undef IN
#undef SEAM
}

extern "C" void kernel_launch(void* const* d_in, const int* in_sizes, int n_in, void* d_out, int out_size, void* d_ws, size_t ws_size, hipStream_t stream) {
    static int grid = 0;
    if (grid == 0) {
        if (n_in != N_IN || out_size != (int)O_END || ws_size < WS_END) { fprintf(stderr, "kernel_launch: unexpected problem: n_in %d out %d ws %zu\n", n_in, out_size, ws_size); grid = -1; return; }
        int dev = 0, cus = 0, per_cu = 0;
        if (hipGetDevice(&dev) != hipSuccess || hipDeviceGetAttribute(&cus, hipDeviceAttributeMultiprocessorCount, dev) != hipSuccess) { grid = -1; return; }
        if (hipFuncSetAttribute((const void*)fwd_megakernel, hipFuncAttributeMaxDynamicSharedMemorySize, LDS_BYTES) != hipSuccess) { fprintf(stderr, "kernel_launch: hipFuncSetAttribute failed\n"); grid = -1; return; }
        if (hipOccupancyMaxActiveBlocksPerMultiprocessor(&per_cu, (const void*)fwd_megakernel, NWAVES * 64, LDS_BYTES) != hipSuccess || per_cu < 1)
            fprintf(stderr, "kernel_launch: note: occupancy query reports %d workgroups per CU\n", per_cu);
        (void)hipGetLastError();
        grid = cus;
    }
    if (grid < 0) return;
    if (hipMemsetAsync((char*)d_ws + WS_CTL, 0, CTL_ZERO_BYTES, stream) != hipSuccess) { fprintf(stderr, "kernel_launch: memset failed\n"); return; }
    Args a{};
    for (int i = 0; i < N_IN; ++i) a.in[i] = (const float*)d_in[i];
    a.out = (float*)d_out; a.ws = (unsigned char*)d_ws;
#if MK_N_LAUNCHES == 1
    a.ph_lo = 0; a.ph_hi = N_PHASES; a.li = 0;
    hipLaunchKernelGGL(fwd_megakernel, dim3(grid), dim3(NWAVES * 64), LDS_BYTES, stream, a);
#else
    for (int li = 0; li < N_PHASES; ++li) { a.ph_lo = li; a.ph_hi = li + 1; a.li = li;
        hipLaunchKernelGGL(fwd_megakernel, dim3(grid), dim3(NWAVES * 64), LDS_BYTES, stream, a); }
#endif
    const hipError_t le = hipPeekAtLastError();
    if (le != hipSuccess) fprintf(stderr, "kernel_launch: launch failed: %s\n", hipGetErrorName(le));
}
```
